# Optimizing an MI355X kernel written in HIP

```python
import math
import jax, jax.numpy as jnp
from jax import lax
import numpy as np

D_MODEL = 1024
BATCH = 4
SEQ = 8192
DEPTH = 2

PLE_DIM = 256
MIX_WIDTH = D_MODEL
HEAD_DIM = 64
LRU_WIDTH = D_MODEL // 4
LRU_HEADS = LRU_WIDTH // HEAD_DIM
LRU_BLOCK = LRU_WIDTH // LRU_HEADS
LRU_C = 8.0
CONV_K = 4
ATT_WIDTH = D_MODEL // 4
ATT_HEADS = ATT_WIDTH // HEAD_DIM
ATT_BLOCK = 128
SSD_WIDTH = D_MODEL // 2
SSD_HEADS = SSD_WIDTH // HEAD_DIM
SSD_GROUPS = 2
SSD_HEADS_PER_GROUP = SSD_HEADS // SSD_GROUPS
SSD_STATE = 128
SSD_CHUNK = 128
SSD_CONV_DIM = SSD_WIDTH + 2 * SSD_GROUPS * SSD_STATE
FFN_DIM = 128 * ((8 * D_MODEL // 3 + 127) // 128)
ALPHA = (2.0 * DEPTH) ** 0.25
BETA = (8.0 * DEPTH) ** -0.25
LN_EPS = 1e-5
RMS_EPS = 1e-5
IN_SIZES = (LRU_WIDTH, LRU_WIDTH,
            ATT_WIDTH, ATT_WIDTH, ATT_WIDTH,
            ATT_HEADS,
            SSD_WIDTH, SSD_CONV_DIM, SSD_HEADS)
IN_WIDTH = sum(IN_SIZES)

kernel_name = "hymba_style_lru_fox_ssd_macaron_deepnorm"


def _split_points(sizes):
    pts, acc = [], 0
    for s in sizes[:-1]:
        acc += s
        pts.append(acc)
    return pts


def layer_norm(x, g, b):
    xf = x.astype(jnp.float32)
    mu = jnp.mean(xf, axis=-1, keepdims=True)
    var = jnp.mean(jnp.square(xf - mu), axis=-1, keepdims=True)
    y = (xf - mu) * lax.rsqrt(var + LN_EPS) * g.astype(jnp.float32) + b.astype(jnp.float32)
    return y.astype(x.dtype)


def swiglu(x, wg, wu, wd):
    return (jax.nn.silu(x @ wg) * (x @ wu)) @ wd


def causal_dwconv(u, w, b):
    c = u.shape[-1]
    y = lax.conv_general_dilated(u, w[:, None, :].astype(u.dtype), window_strides=(1,),
                                 padding=[(CONV_K - 1, 0)],
                                 dimension_numbers=("NWC", "WIO", "NWC"),
                                 feature_group_count=c)
    return y + b


def _lin_combine(e1, e2):
    a1, b1 = e1
    a2, b2 = e2
    return a1 * a2, a2 * b1 + b2


def rglru_block(u_raw, gate_raw, conv_w, conv_b, wa, ba, wx, bx, lam):
    bsz, s, _ = u_raw.shape
    u = causal_dwconv(u_raw, conv_w, conv_b)
    ub = u.reshape(bsz, s, LRU_HEADS, LRU_BLOCK)
    r = jax.nn.sigmoid(jnp.einsum("bshi,hij->bshj", ub, wa).reshape(bsz, s, LRU_WIDTH) + ba)
    ig = jax.nn.sigmoid(jnp.einsum("bshi,hij->bshj", ub, wx).reshape(bsz, s, LRU_WIDTH) + bx)
    log_a = -LRU_C * r.astype(jnp.float32) * jax.nn.softplus(-lam.astype(jnp.float32))
    a = jnp.exp(log_a)
    b = jnp.sqrt(-jnp.expm1(2.0 * log_a)) * (ig * u).astype(jnp.float32)
    _, h = lax.associative_scan(_lin_combine, (a, b), axis=1)
    return (h * jax.nn.gelu(gate_raw.astype(jnp.float32))).astype(u_raw.dtype)


def forgetting_attention(q, k, v, f_logit, b_f):
    bsz, s, _ = q.shape
    nblk = s // ATT_BLOCK
    log_f = jax.nn.log_sigmoid((f_logit + b_f).astype(jnp.float32))
    F = jnp.cumsum(log_f, axis=1).transpose(0, 2, 1)
    qh = q.astype(jnp.float32).reshape(bsz, s, ATT_HEADS, HEAD_DIM).transpose(0, 2, 1, 3) * (HEAD_DIM ** -0.5)
    kh = k.astype(jnp.float32).reshape(bsz, s, ATT_HEADS, HEAD_DIM).transpose(0, 2, 1, 3)
    vh = v.astype(jnp.float32).reshape(bsz, s, ATT_HEADS, HEAD_DIM).transpose(0, 2, 1, 3)
    q_blocks = qh.reshape(bsz, ATT_HEADS, nblk, ATT_BLOCK, HEAD_DIM).transpose(2, 0, 1, 3, 4)
    f_blocks = F.reshape(bsz, ATT_HEADS, nblk, ATT_BLOCK).transpose(2, 0, 1, 3)
    key_pos = jnp.arange(s)

    def one_block(args):
        qb, fb, bi = args
        logits = jnp.einsum("bhqd,bhkd->bhqk", qb, kh) + fb[..., :, None] - F[:, :, None, :]
        q_pos = bi * ATT_BLOCK + jnp.arange(ATT_BLOCK)
        logits = jnp.where(key_pos[None, :] <= q_pos[:, None], logits, -jnp.inf)
        w = jax.nn.softmax(logits, axis=-1)
        return jnp.einsum("bhqk,bhkd->bhqd", w, vh)

    out = lax.map(one_block, (q_blocks, f_blocks, jnp.arange(nblk)))
    out = out.transpose(1, 0, 3, 2, 4).reshape(bsz, s, ATT_WIDTH)
    return out.astype(q.dtype)


def segsum(x):
    t = x.shape[-1]
    xc = jnp.cumsum(x, axis=-1)
    seg = xc[..., :, None] - xc[..., None, :]
    mask = jnp.tril(jnp.ones((t, t), dtype=bool))
    return jnp.where(mask, seg, -jnp.inf)


def ssd_chunked(xs, a, bm, cm):
    bsz, s, h, p = xs.shape
    n = bm.shape[-1]
    c = s // SSD_CHUNK
    xs = xs.reshape(bsz, c, SSD_CHUNK, h, p)
    bm = bm.reshape(bsz, c, SSD_CHUNK, h, n)
    cm = cm.reshape(bsz, c, SSD_CHUNK, h, n)
    a = a.reshape(bsz, c, SSD_CHUNK, h).transpose(0, 3, 1, 2)
    a_cum = jnp.cumsum(a, axis=-1)
    L = jnp.exp(segsum(a))
    y_diag = jnp.einsum("bclhn,bcshn,bhcls,bcshp->bclhp", cm, bm, L, xs)
    decay_states = jnp.exp(a_cum[..., -1:] - a_cum)
    states = jnp.einsum("bclhn,bhcl,bclhp->bchpn", bm, decay_states, xs)
    states = jnp.concatenate([jnp.zeros_like(states[:, :1]), states], axis=1)
    decay_chunk = jnp.exp(segsum(jnp.pad(a_cum[..., -1], ((0, 0), (0, 0), (1, 0)))))
    states = jnp.einsum("bhzc,bchpn->bzhpn", decay_chunk, states)[:, :-1]
    y_off = jnp.einsum("bclhn,bchpn,bhcl->bclhp", cm, states, jnp.exp(a_cum))
    return (y_diag + y_off).reshape(bsz, s, h, p)


def ssd_mixer(z, xbc_raw, dt_raw, conv_w, conv_b, dt_bias, a_log, d_skip, norm_g):
    bsz, s, _ = z.shape
    xbc = jax.nn.silu(causal_dwconv(xbc_raw, conv_w, conv_b)).astype(jnp.float32)
    xs, bm, cm = jnp.split(xbc, [SSD_WIDTH, SSD_WIDTH + SSD_GROUPS * SSD_STATE], axis=-1)
    dt = jax.nn.softplus((dt_raw + dt_bias).astype(jnp.float32))
    A = -jnp.exp(a_log.astype(jnp.float32))
    xs_h = xs.reshape(bsz, s, SSD_HEADS, HEAD_DIM)
    bm_h = jnp.repeat(bm.reshape(bsz, s, SSD_GROUPS, SSD_STATE), SSD_HEADS_PER_GROUP, axis=2)
    cm_h = jnp.repeat(cm.reshape(bsz, s, SSD_GROUPS, SSD_STATE), SSD_HEADS_PER_GROUP, axis=2)
    y = ssd_chunked(xs_h * dt[..., None], A * dt, bm_h, cm_h)
    y = y + d_skip.astype(jnp.float32)[:, None] * xs_h
    y = y.reshape(bsz, s, SSD_WIDTH) * jax.nn.silu(z.astype(jnp.float32))
    yg = y.reshape(bsz, s, SSD_GROUPS, SSD_WIDTH // SSD_GROUPS)
    yg = yg * lax.rsqrt(jnp.mean(jnp.square(yg), axis=-1, keepdims=True) + RMS_EPS)
    y = yg.reshape(bsz, s, SSD_WIDTH) * norm_g.astype(jnp.float32)
    return y.astype(z.dtype)


def setup_inputs(seed: int = 0) -> dict:
    key = jax.random.key(seed)
    ks = iter(jax.random.split(key, 33))
    f32 = jnp.float32

    def nrm(shape, scale):
        return scale * jax.random.normal(next(ks), shape, f32)

    def gain(shape):
        return 1.0 + nrm(shape, 0.02)

    d = DEPTH
    out = {}
    out["x"] = nrm((BATCH, SEQ, D_MODEL), 1.0)
    out["p"] = nrm((DEPTH, BATCH, SEQ, PLE_DIM), 1.0)
    out["ln1_g"] = gain((d, D_MODEL))
    out["ln1_b"] = nrm((d, D_MODEL), 0.02)
    out["ffn1_wg"] = nrm((d, D_MODEL, FFN_DIM), BETA * D_MODEL ** -0.5)
    out["ffn1_wu"] = nrm((d, D_MODEL, FFN_DIM), BETA * D_MODEL ** -0.5)
    out["ffn1_wd"] = nrm((d, FFN_DIM, D_MODEL), BETA * FFN_DIM ** -0.5)
    out["w_in"] = nrm((d, D_MODEL, IN_WIDTH), D_MODEL ** -0.5)
    out["lru_conv_w"] = nrm((d, CONV_K, LRU_WIDTH), CONV_K ** -0.5)
    out["lru_conv_b"] = nrm((d, LRU_WIDTH), 0.02)
    out["lru_wa"] = nrm((d, LRU_HEADS, LRU_BLOCK, LRU_BLOCK), LRU_BLOCK ** -0.5)
    out["lru_ba"] = nrm((d, LRU_WIDTH), 0.02)
    out["lru_wx"] = nrm((d, LRU_HEADS, LRU_BLOCK, LRU_BLOCK), LRU_BLOCK ** -0.5)
    out["lru_bx"] = nrm((d, LRU_WIDTH), 0.02)
    a_c = jax.random.uniform(next(ks), (d, LRU_WIDTH), f32, 0.9, 0.999)
    a0 = a_c ** (1.0 / LRU_C)
    out["lru_lambda"] = jnp.log(a0) - jnp.log1p(-a0)
    out["fox_bf"] = 3.0 + nrm((d, ATT_HEADS), 0.1)
    out["ssd_conv_w"] = nrm((d, CONV_K, SSD_CONV_DIM), CONV_K ** -0.5)
    out["ssd_conv_b"] = nrm((d, SSD_CONV_DIM), 0.02)
    dt0 = jnp.exp(jax.random.uniform(next(ks), (d, SSD_HEADS), f32, math.log(1e-3), math.log(1e-1)))
    out["ssd_dt_bias"] = dt0 + jnp.log(-jnp.expm1(-dt0))
    out["ssd_a_log"] = jnp.log(jax.random.uniform(next(ks), (d, SSD_HEADS), f32, 1.0, 16.0))
    out["ssd_d"] = gain((d, SSD_HEADS))
    out["ssd_norm_g"] = gain((d, SSD_WIDTH))
    out["w_out"] = nrm((d, MIX_WIDTH, D_MODEL), BETA * MIX_WIDTH ** -0.5)
    out["ln2_g"] = gain((d, D_MODEL))
    out["ln2_b"] = nrm((d, D_MODEL), 0.02)
    out["ffn2_wg"] = nrm((d, D_MODEL, FFN_DIM), BETA * D_MODEL ** -0.5)
    out["ffn2_wu"] = nrm((d, D_MODEL, FFN_DIM), BETA * D_MODEL ** -0.5)
    out["ffn2_wd"] = nrm((d, FFN_DIM, D_MODEL), BETA * FFN_DIM ** -0.5)
    out["ln3_g"] = gain((d, D_MODEL))
    out["ln3_b"] = nrm((d, D_MODEL), 0.02)
    out["pe_proj"] = nrm((d, PLE_DIM, D_MODEL), BETA * PLE_DIM ** -0.5)
    out["pe_gate_w"] = nrm((d, D_MODEL, D_MODEL), D_MODEL ** -0.5)
    out["pe_gate_b"] = nrm((d, D_MODEL), 0.02)
    return out


def reference(x, p, ln1_g, ln1_b, ffn1_wg, ffn1_wu, ffn1_wd, w_in,
              lru_conv_w, lru_conv_b, lru_wa, lru_ba, lru_wx, lru_bx, lru_lambda,
              fox_bf, ssd_conv_w, ssd_conv_b, ssd_dt_bias, ssd_a_log, ssd_d, ssd_norm_g,
              w_out, ln2_g, ln2_b, ffn2_wg, ffn2_wu, ffn2_wd, ln3_g, ln3_b,
              pe_proj, pe_gate_w, pe_gate_b):
    pts = _split_points(IN_SIZES)
    for i in range(DEPTH):
        x = layer_norm(ALPHA * x + 0.5 * swiglu(x, ffn1_wg[i], ffn1_wu[i], ffn1_wd[i]), ln1_g[i], ln1_b[i])
        h = x @ w_in[i]
        u_lru, g_lru, q, k, v, f_logit, z, xbc, dt_raw = jnp.split(h, pts, axis=-1)
        y_a = rglru_block(u_lru, g_lru, lru_conv_w[i], lru_conv_b[i], lru_wa[i], lru_ba[i],
                          lru_wx[i], lru_bx[i], lru_lambda[i])
        y_b = forgetting_attention(q, k, v, f_logit, fox_bf[i])
        y_c = ssd_mixer(z, xbc, dt_raw, ssd_conv_w[i], ssd_conv_b[i], ssd_dt_bias[i],
                        ssd_a_log[i], ssd_d[i], ssd_norm_g[i])
        mix = jnp.concatenate([y_a, y_b, y_c], axis=-1) @ w_out[i]
        x = layer_norm(ALPHA * x + mix, ln2_g[i], ln2_b[i])
        x = layer_norm(ALPHA * x + 0.5 * swiglu(x, ffn2_wg[i], ffn2_wu[i], ffn2_wd[i]), ln3_g[i], ln3_b[i])
        x = x + jax.nn.sigmoid(x @ pe_gate_w[i] + pe_gate_b[i]) * (p[i] @ pe_proj[i])
    return x
```

```cpp
#include <hip/hip_runtime.h>
#include <hip/hip_cooperative_groups.h>
#include <cstdio>
#include <cstdint>
namespace cg = cooperative_groups;
typedef unsigned short bf16;
constexpr int M = 32768, SEQ = 8192, D = 1024, FF = 2816, NIN = 3072, HBW = 2816, NTH = 512;
constexpr int HB_U = 0, HB_G = 256, HB_Q = 512, HB_K = 768, HB_V = 1024, HB_Z = 1280, HB_X = 1792;
constexpr float ALPHA = 1.4142135623730951f, LN_EPS = 1e-5f, RMS_EPS = 1e-5f, LOG2E = 1.4426950408889634f;
constexpr size_t MiB = 1u << 20;
constexpr size_t WS_W0 = 1 * MiB, WS_WL = 44 * MiB;
constexpr size_t OFF_UP1 = 0, OFF_DN1 = 11 * MiB, OFF_WIN = 16 * MiB + MiB / 2, OFF_WOUT = 22 * MiB + MiB / 2, OFF_UP2 = 24 * MiB + MiB / 2, OFF_DN2 = 35 * MiB + MiB / 2,
                 OFF_GATE = 41 * MiB, OFF_PROJ = 43 * MiB, OFF_LRUW = 43 * MiB + MiB / 2;
constexpr size_t WS_XBA = 89 * MiB, WS_XBB = 153 * MiB, WS_H = 217 * MiB, WS_SMALL = 393 * MiB, WS_YCAT = 395 * MiB, WS_MISC = 459 * MiB, WS_PB = 460 * MiB, WS_END = 492 * MiB;
constexpr size_t WS_STATE = WS_XBA;
constexpr size_t MISC_AGG = 0, MISC_CARRY = 512 * 1024, MISC_ATOT = 768 * 1024;
constexpr int LDS_BYTES = 147456;

struct KP { const float* in[33]; float* out; unsigned char* ws; };
__device__ __forceinline__ const float* kp_in(const KP& P, int i) { asm volatile("" : "+s"(i)); return P.in[i]; }
#define PIN(P, i) kp_in((P), (i))
__device__ __forceinline__ unsigned char* kp_ws(const KP& P) { int i = 0; asm volatile("" : "+s"(i)); return *(unsigned char* const*)((const char*)&P.ws + i); }
__device__ __forceinline__ float* kp_out(const KP& P) { int i = 0; asm volatile("" : "+s"(i)); return *(float* const*)((const char*)&P.out + i); }

__device__ __forceinline__ int lane_id_asm() { int l; asm volatile("v_mbcnt_lo_u32_b32 %0, -1, 0\n\tv_mbcnt_hi_u32_b32 %0, -1, %0" : "=v"(l)); return l; }
namespace pg8 {
#define PG8_LAS __attribute__((address_space(3)))
typedef unsigned short bf16_t;
typedef short bf16x8 __attribute__((ext_vector_type(8)));
typedef float f32x4 __attribute__((ext_vector_type(4)));
typedef unsigned u32x4 __attribute__((ext_vector_type(4)));
constexpr int BM = 256, BK = 64, HALF = 128, HTB = HALF * BK * 2  , STAGE_BYTES = 8 * HTB, NXCD = 8, WGM = 8;

__host__ __device__ __forceinline__ int lds_byte(int r, int c) { const int st = (r >> 4) * 2 + (c >> 5), rr = r & 15, cc = c & 31, ob = rr * 64 + cc * 2; return st * 1024 + (ob ^ (((ob >> 9) & 1) << 5)); }
__host__ __device__ __forceinline__ void stage_rc(int b, int& R, int& C) { const int st = b / 1024, sb = b % 1024, swz = sb ^ (((sb >> 9) & 1) << 5); R = (st >> 1) * 16 + swz / 64; C = (st & 1) * 32 + (swz % 64) / 2; }
__host__ __device__ __forceinline__ int perm32(int rho) { const int n = rho >> 4, i = rho & 15; return 8 * (i >> 2) + 4 * n + (i & 3); }

struct Unit { int pm, pn; };
struct Gemm { const bf16_t* A; const bf16_t* Bt; int M, N, K; };

struct StaticOrder {
    int nM, nN, nwg, G, c;
    __host__ __device__ void init(int M, int N, int G_, int c_) { nM = M / BM; nN = N / BM; nwg = nM * nN; G = G_; c = c_; }
    __host__ __device__ bool next(int i, Unit& u) const {
        const long L = (long)i * G + c; if (L >= nwg) return false;
        int wgid = (int)L; { const int q = nwg / NXCD, r = nwg % NXCD, xcd = wgid % NXCD, off = wgid / NXCD; wgid = (xcd < r ? xcd * (q + 1) : r * (q + 1) + (xcd - r) * q) + off; }
        const int nig = WGM * nN, gid = wgid / nig, fm = gid * WGM, gsz = (nM - fm) < WGM ? (nM - fm) : WGM;
        u.pm = fm + ((wgid % nig) % gsz); u.pn = (wgid % nig) / gsz; return true;
    }
    __device__ __forceinline__ void a_ready(const Unit&) const {}
    __device__ __forceinline__ void done(const Unit&) const {}
};

__device__ __forceinline__ unsigned cvt_pk_bf16(float lo, float hi) { unsigned r; asm volatile("v_cvt_pk_bf16_f32 %0, %1, %2" : "=v"(r) : "v"(lo), "v"(hi)); return r; }
typedef float f32x2 __attribute__((ext_vector_type(2)));
typedef unsigned u32x2 __attribute__((ext_vector_type(2)));
__device__ __forceinline__ float fsigmoid(float v) { return __builtin_amdgcn_rcpf(1.0f + __expf(-v)); }
struct EpiSwiGLU {
    static constexpr bool PERM = true, AFTER_DRAIN = false;
    const KP* kp;
    __device__ __forceinline__ void operator()(const f32x4 (&acc)[2][2][4][2], const Unit& u, int wr, int wc, int fr_, int fq_) const {
        const int l_ = lane_id_asm(), fr = l_ & 15, fq = l_ >> 4;
        const int row0 = u.pm * BM + wr * 64 + fr, col0 = u.pn * HALF + wc * 32 + 8 * fq; bf16_t* H = (bf16_t*)(kp_ws(*kp) + WS_H); constexpr int ldh = FF;
#pragma unroll
        for (int ai = 0; ai < 2; ++ai)
#pragma unroll
            for (int m = 0; m < 4; ++m) {
                bf16_t* rowp = H + (size_t)(row0 + ai * HALF + m * 16) * ldh + col0;
                float o[8];
#pragma unroll
                for (int n = 0; n < 2; ++n)
#pragma unroll
                    for (int j = 0; j < 4; ++j) { const float g = acc[ai][0][m][n][j], up = acc[ai][1][m][n][j]; o[4 * n + j] = g * fsigmoid(g) * up; }
                u32x4 w; w.x = cvt_pk_bf16(o[0], o[1]); w.y = cvt_pk_bf16(o[2], o[3]); w.z = cvt_pk_bf16(o[4], o[5]); w.w = cvt_pk_bf16(o[6], o[7]);
                *(u32x4*)rowp = w;
            }
    }
};
struct EpiResid {
    static constexpr bool PERM = true, AFTER_DRAIN = false;
    const KP* kp; int first; float s;
    __device__ __forceinline__ void operator()(const f32x4 (&acc)[2][2][4][2], const Unit& u, int wr, int wc, int fr_, int fq_) const {
        const int l_ = lane_id_asm(), fr = l_ & 15, fq = l_ >> 4;
        const int row0 = u.pm * BM + wr * 64 + fr, col0 = u.pn * BM + wc * 32 + 8 * fq; float* out = kp_out(*kp); const float* res = first ? kp_in(*kp, 0) : (const float*)out; constexpr float alpha = ALPHA;
#pragma unroll
        for (int ai = 0; ai < 2; ++ai)
#pragma unroll
            for (int m = 0; m < 4; ++m) {
                const size_t off = (size_t)(row0 + ai * HALF + m * 16) * 1024 + col0;
#pragma unroll
                for (int bj = 0; bj < 2; ++bj) {
                    const f32x4 r0 = *(const f32x4*)(res + off + bj * HALF), r1 = *(const f32x4*)(res + off + bj * HALF + 4);
                    const f32x4 o0 = r0 * alpha + acc[ai][bj][m][0] * s, o1 = r1 * alpha + acc[ai][bj][m][1] * s;
                    *(f32x4*)(out + off + bj * HALF) = o0; *(f32x4*)(out + off + bj * HALF + 4) = o1;
                }
                asm volatile("" ::: "memory");
            }
    }
};
struct EpiIn {
    static constexpr bool PERM = true, AFTER_DRAIN = false;
    const KP* kp;
    __device__ __forceinline__ void operator()(const f32x4 (&acc)[2][2][4][2], const Unit& u, int wr, int wc, int fr_, int fq_) const {
        const int l_ = lane_id_asm(), fr = l_ & 15, fq = l_ >> 4;
        const int row0 = u.pm * BM + wr * 64 + fr; bf16_t* hb = (bf16_t*)(kp_ws(*kp) + WS_H); float* sm = (float*)(kp_ws(*kp) + WS_SMALL);
        if (u.pn < 11) {
            const int col0 = u.pn * BM + wc * 32 + 8 * fq;
#pragma unroll
            for (int ai = 0; ai < 2; ++ai)
#pragma unroll
                for (int m = 0; m < 4; ++m) {
                    bf16_t* rowp = hb + (size_t)(row0 + ai * HALF + m * 16) * 2816 + col0;
#pragma unroll
                    for (int bj = 0; bj < 2; ++bj) { const f32x4 v0 = acc[ai][bj][m][0], v1 = acc[ai][bj][m][1];
                        u32x4 w; w.x = cvt_pk_bf16(v0[0], v0[1]); w.y = cvt_pk_bf16(v0[2], v0[3]); w.z = cvt_pk_bf16(v1[0], v1[1]); w.w = cvt_pk_bf16(v1[2], v1[3]);
                        *(u32x4*)(rowp + bj * HALF) = w; }
                }
        } else if (wc == 0 && fq < 2) {
#pragma unroll
            for (int ai = 0; ai < 2; ++ai)
#pragma unroll
                for (int m = 0; m < 4; ++m) {
                    float* p = sm + (size_t)(row0 + ai * HALF + m * 16) * 16 + 8 * fq;
                    *(f32x4*)p = acc[ai][0][m][0]; *(f32x4*)(p + 4) = acc[ai][0][m][1];
                }
        }
    }
};
struct EpiF32 {
    static constexpr bool PERM = true, AFTER_DRAIN = false;
    const KP* kp;
    __device__ __forceinline__ void operator()(const f32x4 (&acc)[2][2][4][2], const Unit& u, int wr, int wc, int fr_, int fq_) const {
        const int l_ = lane_id_asm(), fr = l_ & 15, fq = l_ >> 4;
        const int row0 = u.pm * BM + wr * 64 + fr, col0 = u.pn * BM + wc * 32 + 8 * fq; float* O = (float*)(kp_ws(*kp) + WS_H);
#pragma unroll
        for (int ai = 0; ai < 2; ++ai)
#pragma unroll
            for (int m = 0; m < 4; ++m) {
                const size_t off = (size_t)(row0 + ai * HALF + m * 16) * 1024 + col0;
#pragma unroll
                for (int bj = 0; bj < 2; ++bj) { *(f32x4*)(O + off + bj * HALF) = acc[ai][bj][m][0]; *(f32x4*)(O + off + bj * HALF + 4) = acc[ai][bj][m][1]; }
            }
    }
};
struct EpiPE {
    static constexpr bool PERM = true, AFTER_DRAIN = false;
    const KP* kp; int L;
    __device__ __forceinline__ void operator()(const f32x4 (&acc)[2][2][4][2], const Unit& u, int wr, int wc, int fr_, int fq_) const {
        const int l_ = lane_id_asm(), fr = l_ & 15, fq = l_ >> 4;
        const int row0 = u.pm * BM + wr * 64 + fr, col0 = u.pn * BM + wc * 32 + 8 * fq;
        float* x = kp_out(*kp); const float* P = (const float*)(kp_ws(*kp) + WS_H); const float* bias = kp_in(*kp, 32) + L * D; bf16_t* xb = (bf16_t*)(kp_ws(*kp) + WS_XBA);
#pragma unroll
        for (int ai = 0; ai < 2; ++ai)
#pragma unroll
            for (int m = 0; m < 4; ++m) {
                const size_t off = (size_t)(row0 + ai * HALF + m * 16) * 1024 + col0;
#pragma unroll
                for (int bj = 0; bj < 2; ++bj) {
                    f32x4 o[2];
#pragma unroll
                    for (int n = 0; n < 2; ++n) {
                        const f32x4 xv = *(const f32x4*)(x + off + bj * HALF + 4 * n), pv = *(const f32x4*)(P + off + bj * HALF + 4 * n), bv = *(const f32x4*)(bias + col0 + bj * HALF + 4 * n);
                        const f32x4 g = acc[ai][bj][m][n] + bv;
                        f32x4 r; r[0] = xv[0] + fsigmoid(g[0]) * pv[0]; r[1] = xv[1] + fsigmoid(g[1]) * pv[1]; r[2] = xv[2] + fsigmoid(g[2]) * pv[2]; r[3] = xv[3] + fsigmoid(g[3]) * pv[3];
                        o[n] = r; *(f32x4*)(x + off + bj * HALF + 4 * n) = r;
                    }
                    u32x4 w; w.x = cvt_pk_bf16(o[0][0], o[0][1]); w.y = cvt_pk_bf16(o[0][2], o[0][3]); w.z = cvt_pk_bf16(o[1][0], o[1][1]); w.w = cvt_pk_bf16(o[1][2], o[1][3]);
                    *(u32x4*)(xb + off + bj * HALF) = w;
                    asm volatile("" ::: "memory");
                }
            }
    }
};
template <class Epi, class Sched, bool ALIGN_EPI = false, bool SP2 = false>
__device__ __forceinline__ void gemm_phase(PG8_LAS unsigned char* lds, const Gemm g, const Sched& S, const Epi& E, int tid_in) {
    int tid_o = tid_in; asm volatile("" : "+v"(tid_o));
    const int tid = tid_o, wid = __builtin_amdgcn_readfirstlane(tid >> 6), lane = tid & 63, wr = wid >> 2, wc = wid & 3, fr = lane & 15, fq = lane >> 4;
    const int K = g.K, nt = K / BK;
    unsigned voffA[2], voffB[2];
#pragma unroll
    for (int i = 0; i < 2; ++i) { int R, C; stage_rc(tid * 16 + i * 8192, R, C); const int Rb = Epi::PERM ? ((R & ~31) + perm32(R & 31)) : R;
        voffA[i] = (unsigned)(R * K + C) * 2u; voffB[i] = (unsigned)(Rb * K + C) * 2u; }
    const size_t kstep = (size_t)(BK * 2);
    const size_t hstep = (size_t)HALF * K * 2;
    const size_t tstep = 2 * hstep;
    const unsigned ldsw = (unsigned)wid * 1024u;
    const int aoff = lds_byte(wr * 64 + fr, fq * 8), boff = lds_byte(wc * 32 + fr, fq * 8);
#define PG8_SA(b, h) (((b) * 2 + (h)) * HTB)
#define PG8_SB(b, h) ((4 + (b) * 2 + (h)) * HTB)
#define PG8_STAGE(bufoff, gbase, voff) do { _Pragma("unroll") for (int _i = 0; _i < 2; ++_i) \
        __builtin_amdgcn_global_load_lds((const unsigned*)((const char*)(gbase) + (voff)[_i]), (PG8_LAS unsigned*)(lds + (bufoff) + ldsw + _i * 8192), 16, 0, 0); } while (0)
#define PG8_LDA(dst, b, h) do { _Pragma("unroll") for (int m = 0; m < 4; ++m) _Pragma("unroll") for (int k = 0; k < 2; ++k) dst[m][k] = *(const PG8_LAS bf16x8*)(lds + PG8_SA(b, h) + aoff + m * 2048 + k * 1024); } while (0)
#define PG8_LDB(dst, b, h) do { _Pragma("unroll") for (int n = 0; n < 2; ++n) _Pragma("unroll") for (int k = 0; k < 2; ++k) dst[n][k] = *(const PG8_LAS bf16x8*)(lds + PG8_SB(b, h) + boff + n * 2048 + k * 1024); } while (0)
#define PG8_MMA(ai, bj, At, Bt) do { __builtin_amdgcn_s_setprio(1); _Pragma("unroll") for (int m = 0; m < 4; ++m) _Pragma("unroll") for (int n = 0; n < 2; ++n) _Pragma("unroll") for (int k = 0; k < 2; ++k) \
        acc[ai][bj][m][n] = __builtin_amdgcn_mfma_f32_16x16x32_bf16(Bt[n][k], At[m][k], acc[ai][bj][m][n], 0, 0, 0); __builtin_amdgcn_s_setprio(0); } while (0)
#define PG8_WAIT_V(n) asm volatile("s_waitcnt vmcnt(" #n ")" ::: "memory")
#define PG8_WAIT_L(n) asm volatile("s_waitcnt lgkmcnt(" #n ")" ::: "memory")
#define PG8_BAR __builtin_amdgcn_s_barrier()
#define PG8_SCHED __builtin_amdgcn_sched_barrier(0)
    Unit cur, nxt; int ui = 0;
    if (!S.next(0, cur)) return;
    f32x4 acc[2][2][4][2];
#pragma unroll
    for (int a = 0; a < 2; ++a)
#pragma unroll
        for (int b = 0; b < 2; ++b)
#pragma unroll
            for (int m = 0; m < 4; ++m)
#pragma unroll
                for (int n = 0; n < 2; ++n) acc[a][b][m][n] = (f32x4){0.f, 0.f, 0.f, 0.f};
    bf16x8 At[4][2], B0[2][2], B1[2][2];
    const char* cA = (const char*)g.A + (size_t)cur.pm * tstep; const char* cB = (const char*)g.Bt + (size_t)cur.pn * tstep;
    S.a_ready(cur);
    if constexpr (SP2) {
        PG8_STAGE(PG8_SB(0, 0), cB, voffB); PG8_STAGE(PG8_SB(0, 1), cB + hstep, voffB); PG8_STAGE(PG8_SA(0, 0), cA, voffA); PG8_STAGE(PG8_SA(0, 1), cA + hstep, voffA);
        if (wr == 1) PG8_BAR;
        PG8_WAIT_V(2); PG8_BAR;
        PG8_STAGE(PG8_SB(1, 0), cB + kstep, voffB); PG8_STAGE(PG8_SA(1, 0), cA + kstep, voffA); PG8_STAGE(PG8_SB(1, 1), cB + hstep + kstep, voffB);
        PG8_WAIT_V(6); PG8_BAR;
    } else {
        PG8_STAGE(PG8_SB(0, 0), cB, voffB); PG8_STAGE(PG8_SA(0, 0), cA, voffA); PG8_STAGE(PG8_SB(0, 1), cB + hstep, voffB); PG8_STAGE(PG8_SA(0, 1), cA + hstep, voffA);
        if (wr == 1) PG8_BAR;
        PG8_WAIT_V(4); PG8_BAR;
        PG8_STAGE(PG8_SB(1, 0), cB + kstep, voffB); PG8_STAGE(PG8_SA(1, 0), cA + kstep, voffA); PG8_STAGE(PG8_SB(1, 1), cB + hstep + kstep, voffB);
        PG8_WAIT_V(6); PG8_BAR;
    }
    for (;;) {
        const bool has_next = S.next(ui + 1, nxt);
        const char* nA = has_next ? (const char*)g.A + (size_t)nxt.pm * tstep : cA; const char* nB = has_next ? (const char*)g.Bt + (size_t)nxt.pn * tstep : cB;
        for (int t = 0; t < nt; t += 2) {
            const bool last = (t == nt - 2);
            const char* a1 = cA + (size_t)(t + 1) * kstep;
            const char* a2 = last ? nA : cA + (size_t)(t + 2) * kstep; const char* b2 = last ? nB : cB + (size_t)(t + 2) * kstep;
            const char* a3 = a2 + kstep; const char* b3 = b2 + kstep;
            if (last && has_next) S.a_ready(nxt);
            if constexpr (SP2) {
            PG8_LDB(B0, 0, 0); PG8_LDB(B1, 0, 1); PG8_SCHED; PG8_LDA(At, 0, 0); PG8_STAGE(PG8_SA(1, 1), a1 + hstep, voffA);
            PG8_WAIT_V(8); PG8_WAIT_L(0); PG8_BAR; PG8_MMA(0, 0, At, B0); PG8_MMA(0, 1, At, B1); PG8_BAR; PG8_SCHED;
            PG8_LDA(At, 0, 1); PG8_STAGE(PG8_SB(0, 0), b2, voffB); PG8_STAGE(PG8_SB(0, 1), b2 + hstep, voffB); PG8_STAGE(PG8_SA(0, 0), a2, voffA);
            PG8_WAIT_V(8); PG8_WAIT_L(0); PG8_BAR; PG8_MMA(1, 0, At, B0); PG8_MMA(1, 1, At, B1); PG8_BAR; PG8_SCHED;
            PG8_LDB(B0, 1, 0); PG8_LDB(B1, 1, 1); PG8_SCHED; PG8_LDA(At, 1, 0); PG8_STAGE(PG8_SA(0, 1), a2 + hstep, voffA);
            PG8_WAIT_V(8); PG8_WAIT_L(0); PG8_BAR; PG8_MMA(0, 0, At, B0); PG8_MMA(0, 1, At, B1); PG8_BAR; PG8_SCHED;
            PG8_LDA(At, 1, 1); PG8_STAGE(PG8_SB(1, 0), b3, voffB); PG8_STAGE(PG8_SB(1, 1), b3 + hstep, voffB); PG8_STAGE(PG8_SA(1, 0), a3, voffA);
            PG8_WAIT_V(8); PG8_WAIT_L(0); PG8_BAR; PG8_MMA(1, 0, At, B0); PG8_MMA(1, 1, At, B1); PG8_BAR; PG8_SCHED;
            } else {
            PG8_LDB(B0, 0, 0); PG8_SCHED; PG8_LDA(At, 0, 0); PG8_STAGE(PG8_SA(1, 1), a1 + hstep, voffA);
            PG8_WAIT_L(8); PG8_BAR; PG8_WAIT_L(0); PG8_MMA(0, 0, At, B0); PG8_BAR; PG8_SCHED;
            PG8_LDB(B1, 0, 1); PG8_STAGE(PG8_SB(0, 0), b2, voffB);
            PG8_BAR; PG8_WAIT_L(0); PG8_MMA(0, 1, At, B1); PG8_BAR;
            PG8_LDA(At, 0, 1); PG8_STAGE(PG8_SA(0, 0), a2, voffA);
            PG8_BAR; PG8_WAIT_L(0); PG8_MMA(1, 0, At, B0); PG8_BAR; PG8_SCHED;
            PG8_STAGE(PG8_SB(0, 1), b2 + hstep, voffB);
            PG8_WAIT_V(6); PG8_BAR; PG8_MMA(1, 1, At, B1); PG8_BAR;
            PG8_LDB(B0, 1, 0); PG8_SCHED; PG8_LDA(At, 1, 0); PG8_STAGE(PG8_SA(0, 1), a2 + hstep, voffA);
            PG8_WAIT_L(8); PG8_BAR; PG8_WAIT_L(0); PG8_MMA(0, 0, At, B0); PG8_BAR; PG8_SCHED;
            PG8_LDB(B1, 1, 1); PG8_STAGE(PG8_SB(1, 0), b3, voffB);
            PG8_BAR; PG8_WAIT_L(0); PG8_MMA(0, 1, At, B1); PG8_BAR;
            PG8_LDA(At, 1, 1); PG8_STAGE(PG8_SA(1, 0), a3, voffA);
            PG8_BAR; PG8_WAIT_L(0); PG8_MMA(1, 0, At, B0); PG8_BAR; PG8_SCHED;
            PG8_STAGE(PG8_SB(1, 1), b3 + hstep, voffB);
            PG8_WAIT_V(6); PG8_BAR; PG8_MMA(1, 1, At, B1); PG8_BAR;
            }
        }
        if constexpr (ALIGN_EPI) { if (wr == 0) PG8_BAR; }
        if constexpr (!Epi::AFTER_DRAIN) { E(acc, cur, wr, wc, fr, fq); S.done(cur); }
        if (!has_next) break;
#pragma unroll
        for (int a = 0; a < 2; ++a)
#pragma unroll
            for (int b = 0; b < 2; ++b)
#pragma unroll
                for (int m = 0; m < 4; ++m)
#pragma unroll
                    for (int n = 0; n < 2; ++n) acc[a][b][m][n] = (f32x4){0.f, 0.f, 0.f, 0.f};
        cur = nxt; cA = nA; cB = nB; ++ui;
        if constexpr (ALIGN_EPI) { if (wr == 1) PG8_BAR; }
    }
    PG8_WAIT_V(0);
    if constexpr (!ALIGN_EPI) { if (wr == 0) PG8_BAR; }
    PG8_BAR;
    if constexpr (Epi::AFTER_DRAIN) { E.fused(acc, cur, wr, wc, fr, fq, lds, wid, lane); S.done(cur); }
#undef PG8_SA
#undef PG8_SB
#undef PG8_STAGE
#undef PG8_LDA
#undef PG8_LDB
#undef PG8_MMA
#undef PG8_WAIT_V
#undef PG8_WAIT_L
#undef PG8_BAR
#undef PG8_SCHED
}
}
#define LAS __attribute__((address_space(3)))
#define DI __device__ __forceinline__
typedef short bf16x8 __attribute__((ext_vector_type(8)));
typedef float f32x4 __attribute__((ext_vector_type(4)));
typedef float f32x16 __attribute__((ext_vector_type(16)));
typedef unsigned u32x4 __attribute__((ext_vector_type(4)));
typedef unsigned u32x2 __attribute__((ext_vector_type(2)));
typedef float f32x2_t __attribute__((ext_vector_type(2)));
typedef __bf16 bf16x2_t __attribute__((ext_vector_type(2)));
#define MFMA32(a, b, c) __builtin_amdgcn_mfma_f32_32x32x16_bf16((a), (b), (c), 0, 0, 0)

DI unsigned pk2(float lo, float hi) { f32x2_t v = {lo, hi}; bf16x2_t b = __builtin_convertvector(v, bf16x2_t); return __builtin_bit_cast(unsigned, b); }
DI float bf2f(unsigned short b) { return __uint_as_float((unsigned)b << 16); }
DI float bflo(unsigned w) { return __uint_as_float(w << 16); }
DI float bfhi(unsigned w) { return __uint_as_float(w & 0xffff0000u); }
DI void grid_bar(unsigned* ctr, unsigned target, int tid) {
    asm volatile("s_waitcnt vmcnt(0)" ::: "memory");
    __syncthreads();
    if (tid == 0) {
        __builtin_amdgcn_fence(__ATOMIC_RELEASE, "agent");
        asm volatile("s_waitcnt vmcnt(0)" ::: "memory");
        __hip_atomic_fetch_add(ctr, 1u, __ATOMIC_RELAXED, __HIP_MEMORY_SCOPE_AGENT);
        while (__hip_atomic_load(ctr, __ATOMIC_RELAXED, __HIP_MEMORY_SCOPE_AGENT) < target) __builtin_amdgcn_s_sleep(2);
        __builtin_amdgcn_fence(__ATOMIC_ACQUIRE, "agent");
        asm volatile("s_waitcnt vmcnt(0)" ::: "memory");
    }
    __syncthreads();
}
DI float shx(float v, int mask, int lane) { return __builtin_bit_cast(float, __builtin_amdgcn_ds_bpermute((lane ^ mask) << 2, __builtin_bit_cast(int, v))); }
DI float shup(float v, int o, int lane) { return __builtin_bit_cast(float, __builtin_amdgcn_ds_bpermute(((lane - o) & 63) << 2, __builtin_bit_cast(int, v))); }
DI float wave_sum(float v, int lane) {
#pragma unroll
    for (int o = 1; o < 64; o <<= 1) v += shx(v, o, lane);
    return v;
}
DI float softplusf(float v) { return fmaxf(v, 0.f) + log1pf(__expf(-fabsf(v))); }
DI float sigmoidf_(float v) { return 1.0f / (1.0f + __expf(-v)); }
DI int crow(int r, int hi) { return (r & 3) + 8 * (r >> 2) + 4 * hi; }
DI bf16x8 pack8(float a0, float a1, float a2, float a3, float a4, float a5, float a6, float a7) {
    u32x4 w; w.x = pk2(a0, a1); w.y = pk2(a2, a3); w.z = pk2(a4, a5); w.w = pk2(a6, a7); return __builtin_bit_cast(bf16x8, w);
}

DI void transpose_item(const float* W, int K, int N, bf16* WT, int mode, LAS float* scr, int item, int lane) {
    const int nblk = N / 32, kb = item / nblk, nb = item % nblk, k0 = 64 * kb, n0 = 32 * nb;
#pragma unroll 8
    for (int i = 0; i < 32; ++i) { const int kk = 2 * i + (lane >> 5); scr[kk * 33 + (lane & 31)] = W[(size_t)(k0 + kk) * N + n0 + (lane & 31)]; }
    asm volatile("s_waitcnt lgkmcnt(0)" ::: "memory");
    const int c = lane & 7;
    const int rbase = (mode == 0) ? n0 : (256 * (n0 >> 7) + (n0 & 127) + (mode == 2 ? 128 : 0));
#pragma unroll
    for (int j = 0; j < 4; ++j) { const int n = (lane >> 3) + 8 * j; const LAS float* s = scr + (8 * c) * 33 + n;
        u32x4 o; o.x = pk2(s[0 * 33], s[1 * 33]); o.y = pk2(s[2 * 33], s[3 * 33]); o.z = pk2(s[4 * 33], s[5 * 33]); o.w = pk2(s[6 * 33], s[7 * 33]);
        *(u32x4*)(WT + (size_t)(rbase + n) * K + k0 + 8 * c) = o; }
    asm volatile("s_waitcnt lgkmcnt(0)" ::: "memory");
}
DI int win_src(int n) { return n < 1280 ? n : (n < 2816 ? n + 4 : (n < 2820 ? 1280 + (n - 2816) : (n < 2828 ? n : -1))); }

DI void prologue(const KP& P, LAS unsigned char* lds, int tid, int lane, int wid, int bxo, int Go) {
    LAS float* scr = (LAS float*)(lds + wid * 16384);
    const int gw = bxo * 8 + wid, NGW = Go * 8;
    const size_t gt = (size_t)bxo * NTH + tid, NGT = (size_t)Go * NTH;
    constexpr int I_UP = 16 * 88, I_DN = 44 * 32, I_SQ = 16 * 32, I_PR = 4 * 32, I_WIN = 384 * 16;
    constexpr int PER = 4 * I_UP + 2 * I_DN + 2 * I_SQ + I_PR + I_WIN;
    for (int it = gw; it < 2 * PER; it += NGW) {
        const int L = it / PER; int r = it % PER;
        unsigned char* wl = kp_ws(P) + WS_W0 + (size_t)L * WS_WL;
        if (r < I_UP) { transpose_item(PIN(P, 4) + (size_t)L * D * FF, D, FF, (bf16*)(wl + OFF_UP1), 1, scr, r, lane); continue; } r -= I_UP;
        if (r < I_UP) { transpose_item(PIN(P, 5) + (size_t)L * D * FF, D, FF, (bf16*)(wl + OFF_UP1), 2, scr, r, lane); continue; } r -= I_UP;
        if (r < I_DN) { transpose_item(PIN(P, 6) + (size_t)L * D * FF, FF, D, (bf16*)(wl + OFF_DN1), 0, scr, r, lane); continue; } r -= I_DN;
        if (r < I_SQ) { transpose_item(PIN(P, 22) + (size_t)L * D * D, D, D, (bf16*)(wl + OFF_WOUT), 0, scr, r, lane); continue; } r -= I_SQ;
        if (r < I_UP) { transpose_item(PIN(P, 25) + (size_t)L * D * FF, D, FF, (bf16*)(wl + OFF_UP2), 1, scr, r, lane); continue; } r -= I_UP;
        if (r < I_UP) { transpose_item(PIN(P, 26) + (size_t)L * D * FF, D, FF, (bf16*)(wl + OFF_UP2), 2, scr, r, lane); continue; } r -= I_UP;
        if (r < I_DN) { transpose_item(PIN(P, 27) + (size_t)L * D * FF, FF, D, (bf16*)(wl + OFF_DN2), 0, scr, r, lane); continue; } r -= I_DN;
        if (r < I_SQ) { transpose_item(PIN(P, 31) + (size_t)L * D * D, D, D, (bf16*)(wl + OFF_GATE), 0, scr, r, lane); continue; } r -= I_SQ;
        if (r < I_PR) { transpose_item(PIN(P, 30) + (size_t)L * 256 * D, 256, D, (bf16*)(wl + OFF_PROJ), 0, scr, r, lane); continue; } r -= I_PR;
        {
            const float* W = PIN(P, 7) + (size_t)L * D * 2828; bf16* WT = (bf16*)(wl + OFF_WIN);
            const int n = 8 * (r / 16) + (lane >> 3), kc = 8 * (r % 16) + (lane & 7), src = win_src(n);
            float v[8];
#pragma unroll
            for (int i = 0; i < 8; ++i) v[i] = (src >= 0) ? W[(size_t)(8 * kc + i) * 2828 + src] : 0.f;
            u32x4 o; o.x = pk2(v[0], v[1]); o.y = pk2(v[2], v[3]); o.z = pk2(v[4], v[5]); o.w = pk2(v[6], v[7]);
            *(u32x4*)(WT + (size_t)n * D + 8 * kc) = o;
        }
    }
    for (size_t e = gt; e < 2 * 2 * 16384; e += NGT) {
        const int L = (int)(e >> 15), which = (int)(e >> 14) & 1, idx = (int)(e & 16383), h = idx >> 12, n = (idx >> 6) & 63, k = idx & 63;
        const float* s10 = PIN(P, 10); const float* s12 = PIN(P, 12); const float* src = (which ? s12 : s10) + (size_t)L * 16384;
        bf16* dst = (bf16*)(kp_ws(P) + WS_W0 + (size_t)L * WS_WL + OFF_LRUW) + which * 16384;
        dst[idx] = (bf16)(pk2(src[(h * 64 + k) * 64 + n], 0.f) & 0xffffu);
    }
    {
        const f32x4* x4 = (const f32x4*)PIN(P, 0); u32x4* o = (u32x4*)(kp_ws(P) + WS_XBA);
        for (size_t e = gt; e < (size_t)M * D / 8; e += NGT) { const f32x4 a = x4[2 * e], b = x4[2 * e + 1]; u32x4 w; w.x = pk2(a[0], a[1]); w.y = pk2(a[2], a[3]); w.z = pk2(b[0], b[1]); w.w = pk2(b[2], b[3]); o[e] = w; }
        const f32x4* p4 = (const f32x4*)PIN(P, 1); u32x4* po = (u32x4*)(kp_ws(P) + WS_PB);
        for (size_t e = gt; e < (size_t)2 * M * 256 / 8; e += NGT) { const f32x4 a = p4[2 * e], b = p4[2 * e + 1]; u32x4 w; w.x = pk2(a[0], a[1]); w.y = pk2(a[2], a[3]); w.z = pk2(b[0], b[1]); w.w = pk2(b[2], b[3]); po[e] = w; }
    }
}

DI void ln_phase(float* x, const float* g, const float* bta, bf16* xb, int lane, int wid, int bxo, int Go) {
    const int gw = bxo * 8 + wid, NGW = Go * 8;
    for (int m = gw; m < M; m += NGW) {
        f32x4* xr = (f32x4*)(x + (size_t)m * D) + lane;
        f32x4 v[4]; float s = 0.f;
#pragma unroll
        for (int j = 0; j < 4; ++j) { v[j] = xr[64 * j]; s += (v[j][0] + v[j][1]) + (v[j][2] + v[j][3]); }
        const float mean = wave_sum(s, lane) * (1.f / D); float s2 = 0.f;
#pragma unroll
        for (int j = 0; j < 4; ++j) { v[j] = v[j] - mean; s2 += (v[j][0] * v[j][0] + v[j][1] * v[j][1]) + (v[j][2] * v[j][2] + v[j][3] * v[j][3]); }
        const float rstd = 1.f / sqrtf(wave_sum(s2, lane) * (1.f / D) + LN_EPS);
        u32x2* o8 = (u32x2*)(xb + (size_t)m * D) + lane;
#pragma unroll
        for (int j = 0; j < 4; ++j) {
            const f32x4 gg = ((const f32x4*)g)[lane + 64 * j], bb = ((const f32x4*)bta)[lane + 64 * j];
            const f32x4 o = v[j] * rstd * gg + bb; xr[64 * j] = o;
            u32x2 w; w.x = pk2(o[0], o[1]); w.y = pk2(o[2], o[3]); o8[64 * j] = w;
        }
    }
}
constexpr int AT_KV = 32768, AT_TILE = 9216, AT_RED = AT_KV + 4 * AT_TILE;
DI void attn_unit(const bf16* hb, bf16* ycat, LAS unsigned char* lds, int b, int h, int qb, int tid, int lane, int wid) {
    LAS const float* Fs = (LAS const float*)lds;
    const int q0 = 256 * qb + 32 * wid, qi = lane & 31, hi = lane >> 5;
    const size_t rowbase = (size_t)b * SEQ;
    constexpr float C2 = 0.125f * LOG2E;
    bf16x8 qf[4];
    {
        const bf16* qp = hb + (rowbase + q0 + qi) * HBW + HB_Q + 64 * h + 8 * hi;
#pragma unroll
        for (int d0 = 0; d0 < 4; ++d0) { const u32x4 w = *(const u32x4*)(qp + 16 * d0);
            qf[d0] = pack8(bflo(w.x) * C2, bfhi(w.x) * C2, bflo(w.y) * C2, bfhi(w.y) * C2, bflo(w.z) * C2, bfhi(w.z) * C2, bflo(w.w) * C2, bfhi(w.w) * C2); }
    }
    const float fq2 = Fs[q0 + qi];
    float mrun = -1e30f, lrun = 0.f;
    f32x16 ot0, ot1;
#pragma unroll
    for (int r = 0; r < 16; ++r) { ot0[r] = 0.f; ot1[r] = 0.f; }
    const int ntiles = 4 * (qb + 1);
    const int krow = tid >> 3, kch = tid & 7, vrow = tid & 63, vch = tid >> 6;
    const bf16* kg = hb + (rowbase + krow) * HBW + HB_K + 64 * h + 8 * kch;
    const bf16* vg = hb + (rowbase + vrow) * HBW + HB_V + 64 * h + 8 * vch;
    u32x4 kreg = *(const u32x4*)kg, vreg = *(const u32x4*)vg;
    const int a = lane & 31, pa = (a & 0x13) | ((a & 4) << 1) | ((a & 8) >> 1);
    __syncthreads();
#define AT_STORE(buf) do { LAS unsigned char* Kb_ = lds + AT_KV + (buf) * AT_TILE; LAS unsigned char* Vb_ = lds + AT_KV + 2 * AT_TILE + (buf) * AT_TILE; \
        *(LAS u32x4*)(Kb_ + krow * 144 + 16 * kch) = kreg; \
        LAS unsigned short* vp_ = (LAS unsigned short*)(Vb_ + (8 * vch) * 144 + 2 * vrow); \
        vp_[0 * 72] = (unsigned short)(vreg.x & 0xffffu); vp_[1 * 72] = (unsigned short)(vreg.x >> 16); vp_[2 * 72] = (unsigned short)(vreg.y & 0xffffu); vp_[3 * 72] = (unsigned short)(vreg.y >> 16); \
        vp_[4 * 72] = (unsigned short)(vreg.z & 0xffffu); vp_[5 * 72] = (unsigned short)(vreg.z >> 16); vp_[6 * 72] = (unsigned short)(vreg.w & 0xffffu); vp_[7 * 72] = (unsigned short)(vreg.w >> 16); } while (0)
    AT_STORE(0);
    __syncthreads();
    for (int jt = 0; jt < ntiles; ++jt) {
        const int buf = jt & 1;
        if (jt + 1 < ntiles) { kreg = *(const u32x4*)(kg + (size_t)(jt + 1) * 64 * HBW); vreg = *(const u32x4*)(vg + (size_t)(jt + 1) * 64 * HBW); }
        if (64 * jt <= q0 + 31) {
            LAS const unsigned char* Kb = lds + AT_KV + buf * AT_TILE; LAS const unsigned char* Vb = lds + AT_KV + 2 * AT_TILE + buf * AT_TILE;
            f32x16 sp[2];
#pragma unroll
            for (int p = 0; p < 2; ++p) {
                LAS const float* fk = Fs + 64 * jt + 32 * p + 8 * hi;
                const f32x4 f0 = *(LAS const f32x4*)fk, f1 = *(LAS const f32x4*)(fk + 4), f2 = *(LAS const f32x4*)(fk + 16), f3 = *(LAS const f32x4*)(fk + 20);
#pragma unroll
                for (int j = 0; j < 4; ++j) { sp[p][j] = fq2 - f0[j]; sp[p][4 + j] = fq2 - f1[j]; sp[p][8 + j] = fq2 - f2[j]; sp[p][12 + j] = fq2 - f3[j]; }
#pragma unroll
                for (int d0 = 0; d0 < 4; ++d0) {
                    const bf16x8 kf = *(LAS const bf16x8*)(Kb + (32 * p + pa) * 144 + (16 * d0 + 8 * hi) * 2);
                    sp[p] = MFMA32(kf, qf[d0], sp[p]);
                }
            }
            if (64 * jt + 63 > q0) {
                const int qabs = q0 + qi;
#pragma unroll
                for (int p = 0; p < 2; ++p)
#pragma unroll
                    for (int r = 0; r < 16; ++r) { const int kv = 64 * jt + 32 * p + 16 * (r >> 3) + 8 * hi + (r & 7); if (kv > qabs) sp[p][r] = -1e30f; }
            }
            float mx = sp[0][0];
#pragma unroll
            for (int r = 1; r < 16; ++r) mx = fmaxf(mx, sp[0][r]);
#pragma unroll
            for (int r = 0; r < 16; ++r) mx = fmaxf(mx, sp[1][r]);
            mx = fmaxf(mx, shx(mx, 32, lane));
            const float mn = fmaxf(mrun, mx), alpha = __builtin_amdgcn_exp2f(mrun - mn);
            mrun = mn;
            float ls = 0.f;
#pragma unroll
            for (int p = 0; p < 2; ++p)
#pragma unroll
                for (int r = 0; r < 16; ++r) { const float e = __builtin_amdgcn_exp2f(sp[p][r] - mn); sp[p][r] = e; ls += e; }
            lrun = lrun * alpha + ls;
#pragma unroll
            for (int r = 0; r < 16; ++r) { ot0[r] *= alpha; ot1[r] *= alpha; }
            bf16x8 pf[4];
#pragma unroll
            for (int c = 0; c < 4; ++c) { const int p = c >> 1, s8 = 8 * (c & 1);
                pf[c] = pack8(sp[p][s8 + 0], sp[p][s8 + 1], sp[p][s8 + 2], sp[p][s8 + 3], sp[p][s8 + 4], sp[p][s8 + 5], sp[p][s8 + 6], sp[p][s8 + 7]); }
#pragma unroll
            for (int c = 0; c < 4; ++c) {
                const bf16x8 v0 = *(LAS const bf16x8*)(Vb + (a) * 144 + (16 * c + 8 * hi) * 2);
                const bf16x8 v1 = *(LAS const bf16x8*)(Vb + (32 + a) * 144 + (16 * c + 8 * hi) * 2);
                ot0 = MFMA32(v0, pf[c], ot0); ot1 = MFMA32(v1, pf[c], ot1);
            }
        }
        if (jt + 1 < ntiles) AT_STORE(buf ^ 1);
        __syncthreads();
    }
#undef AT_STORE
    lrun += shx(lrun, 32, lane);
    const float inv = 1.0f / lrun;
    bf16* yp = ycat + (rowbase + q0 + qi) * D + 256 + 64 * h + 4 * hi;
#pragma unroll
    for (int g = 0; g < 4; ++g) {
        u32x2 w0; w0.x = pk2(ot0[4 * g] * inv, ot0[4 * g + 1] * inv); w0.y = pk2(ot0[4 * g + 2] * inv, ot0[4 * g + 3] * inv);
        u32x2 w1; w1.x = pk2(ot1[4 * g] * inv, ot1[4 * g + 1] * inv); w1.y = pk2(ot1[4 * g + 2] * inv, ot1[4 * g + 3] * inv);
        *(u32x2*)(yp + 8 * g) = w0; *(u32x2*)(yp + 32 + 8 * g) = w1;
    }
}
DI void attn_block(const KP& P, int L, LAS unsigned char* lds, int u, int tid, int lane, int wid) {
    const int bh = u >> 4, j = u & 15, b = bh >> 2, h = bh & 3;
    const bf16* hb = (const bf16*)(kp_ws(P) + WS_H); bf16* ycat = (bf16*)(kp_ws(P) + WS_YCAT);
    const float* sm = (const float*)(kp_ws(P) + WS_SMALL);
    LAS float* Fs = (LAS float*)lds; LAS float* red = (LAS float*)(lds + AT_RED);
    const int n = 256 * (32 - j);
    const float bf = PIN(P, 15)[L * 4 + h];
    const float* fl = sm + (size_t)b * SEQ * 16 + h;
    const int s0 = tid * 16;
    float loc[16]; float run = 0.f;
    __syncthreads();
#pragma unroll
    for (int i = 0; i < 16; ++i) { float lf = 0.f; if (s0 < n) { const float v = fl[(size_t)(s0 + i) * 16] + bf; lf = -softplusf(-v); } run += lf; loc[i] = run; }
    float incl = run;
#pragma unroll
    for (int o = 1; o < 64; o <<= 1) { const float t = shup(incl, o, lane); if (lane >= o) incl += t; }
    if (lane == 63) red[wid] = incl;
    __syncthreads();
    float base = incl - run;
    for (int w = 0; w < wid; ++w) base += red[w];
    if (s0 < n) {
#pragma unroll
        for (int i = 0; i < 16; ++i) Fs[s0 + i] = (base + loc[i]) * LOG2E;
    }
    __syncthreads();
    attn_unit(hb, ycat, lds, b, h, 31 - j, tid, lane, wid);
    attn_unit(hb, ycat, lds, b, h, j, tid, lane, wid);
}
constexpr int LR_UF = 16896, LR_AS = LR_UF + 32768, LR_BS = LR_AS + 32768;
DI float gelu_tanh(float x) { const float y = 0.7978845608028654f * (x + 0.044715f * x * x * x); const float t = 1.0f - 2.0f / (__expf(2.0f * y) + 1.0f); return 0.5f * x * (1.0f + t); }
template <bool PASS2>
DI void lru_unit(const KP& P, int L, LAS unsigned char* lds, int b, int c, int tid, int lane, int wid) {
    const bf16* hb = (const bf16*)(kp_ws(P) + WS_H); bf16* ycat = (bf16*)(kp_ws(P) + WS_YCAT);
    float* agg = (float*)(kp_ws(P) + WS_MISC + MISC_AGG); const float* carry = (const float*)(kp_ws(P) + WS_MISC + MISC_CARRY);
    const float* cw = PIN(P, 8) + (size_t)L * 4 * 256; const float* cb = PIN(P, 9) + (size_t)L * 256;
    const float* ba = PIN(P, 11) + (size_t)L * 256; const float* bx = PIN(P, 13) + (size_t)L * 256; const float* lam = PIN(P, 14) + (size_t)L * 256;
    const bf16* waT = (const bf16*)(kp_ws(P) + WS_W0 + (size_t)L * WS_WL + OFF_LRUW); const bf16* wxT = waT + 16384;
    LAS unsigned short* Ubf = (LAS unsigned short*)lds; LAS float* Uf = (LAS float*)(lds + LR_UF); LAS float* As = (LAS float*)(lds + LR_AS); LAS float* Bs = (LAS float*)(lds + LR_BS);
    const int ch = tid & 255, half = tid >> 8, hi = lane >> 5;
    const float w0 = cw[ch], w1 = cw[256 + ch], w2 = cw[512 + ch], w3 = cw[768 + ch], cbias = cb[ch];
    const int hd = wid >> 1, nh = wid & 1, nn = 32 * nh + (lane & 31), chn = 64 * hd + nn;
    bf16x8 wfa[4], wfx[4];
#pragma unroll
    for (int kc = 0; kc < 4; ++kc) { wfa[kc] = *(const bf16x8*)(waT + (hd * 64 + nn) * 64 + 16 * kc + 8 * hi); wfx[kc] = *(const bf16x8*)(wxT + (hd * 64 + nn) * 64 + 16 * kc + 8 * hi); }
    const float ba_c = ba[chn], bx_c = bx[chn], spl = 8.0f * softplusf(-lam[chn]);
    float hstate = 0.f, aprod = 1.f;
    if (PASS2) hstate = carry[((size_t)b * 64 + c) * 256 + ch];
    const size_t t0 = (size_t)b * SEQ + 128 * c;
    __syncthreads();
    for (int sub = 0; sub < 4; ++sub) {
        const size_t ts = t0 + 32 * sub; const int tt = 16 * half, pos = 128 * c + 32 * sub + tt;
        {
            const bf16* up = hb + (ts + tt) * HBW + HB_U + ch;
            float rm3 = (pos >= 3) ? bf2f(*(up - 3 * HBW)) : 0.f, rm2 = (pos >= 2) ? bf2f(*(up - 2 * HBW)) : 0.f, rm1 = (pos >= 1) ? bf2f(*(up - 1 * HBW)) : 0.f;
#pragma unroll 4
            for (int i = 0; i < 16; ++i) { const float cur = bf2f(up[(size_t)i * HBW]); const float uu = w0 * rm3 + w1 * rm2 + w2 * rm1 + w3 * cur + cbias; rm3 = rm2; rm2 = rm1; rm1 = cur;
                Uf[(tt + i) * 256 + ch] = uu; Ubf[(tt + i) * 264 + ch] = (unsigned short)(pk2(uu, 0.f) & 0xffffu); }
        }
        __syncthreads();
        {
            f32x16 ga, gx;
#pragma unroll
            for (int r = 0; r < 16; ++r) { ga[r] = 0.f; gx[r] = 0.f; }
#pragma unroll
            for (int kc = 0; kc < 4; ++kc) { const bf16x8 af = *(LAS const bf16x8*)((LAS const unsigned char*)Ubf + (lane & 31) * 528 + (64 * hd + 16 * kc + 8 * hi) * 2);
                ga = MFMA32(af, wfa[kc], ga); gx = MFMA32(af, wfx[kc], gx); }
#pragma unroll
            for (int r = 0; r < 16; ++r) { const int t = crow(r, hi); const float uu = Uf[t * 256 + chn];
                const float rg = sigmoidf_(ga[r] + ba_c), ig = sigmoidf_(gx[r] + bx_c), la = -spl * rg;
                As[t * 256 + chn] = __expf(la); Bs[t * 256 + chn] = sqrtf(fmaxf(-expm1f(2.0f * la), 0.f)) * ig * uu; }
        }
        __syncthreads();
        if (tid < 256) {
#pragma unroll 8
            for (int t = 0; t < 32; ++t) { const float av = As[t * 256 + ch], bv = Bs[t * 256 + ch]; hstate = av * hstate + bv; aprod *= av;
                if (PASS2) { const float gt = bf2f(hb[(ts + t) * HBW + HB_G + ch]); ycat[(ts + t) * D + ch] = (bf16)(pk2(hstate * gelu_tanh(gt), 0.f) & 0xffffu); } }
        }
        __syncthreads();
    }
    if (!PASS2 && tid < 256) { agg[(((size_t)b * 64 + c) * 256 + ch) * 2] = aprod; agg[(((size_t)b * 64 + c) * 256 + ch) * 2 + 1] = hstate; }
}
DI void lru_carry(const KP& P, int tid, int bxo) {
    const float* agg = (const float*)(kp_ws(P) + WS_MISC + MISC_AGG); float* carry = (float*)(kp_ws(P) + WS_MISC + MISC_CARRY);
    const int e = bxo * NTH + tid;
    if (e < 1024) { const int b = e >> 8, ch = e & 255; float h = 0.f;
        for (int c = 0; c < 64; ++c) { const size_t i = ((size_t)b * 64 + c) * 256 + ch; carry[i] = h; h = agg[2 * i] * h + agg[2 * i + 1]; } }
}
constexpr int SD_XT = 0, SD_B = 69632, SD_C = 104448, SD_DT = 139264, SD_AC = 141312, SD_FR = 143360;
template <bool PASS2>
DI void ssd_conv(const KP& P, int L, LAS unsigned char* lds, int b, int c, int g, int tid) {
    const bf16* hb = (const bf16*)(kp_ws(P) + WS_H);
    if (!PASS2 && tid >= 384) return;
    const int cc = tid < 256 ? 256 * g + tid : (tid < 384 ? 512 + 128 * g + (tid - 256) : 768 + 128 * g + (tid - 384));
    const float* cw = PIN(P, 16) + (size_t)L * 4 * 1024 + cc; const float cbias = PIN(P, 17)[(size_t)L * 1024 + cc];
    const float w0 = cw[0], w1 = cw[1024], w2 = cw[2048], w3 = cw[3072];
    const size_t t0 = (size_t)b * SEQ + 128 * c;
    const bf16* up = hb + t0 * HBW + HB_X + cc;
    float rm3 = 0.f, rm2 = 0.f, rm1 = 0.f;
    if (c > 0) { rm3 = bf2f(*(up - 3 * HBW)); rm2 = bf2f(*(up - 2 * HBW)); rm1 = bf2f(*(up - 1 * HBW)); }
    for (int t8 = 0; t8 < 16; ++t8) {
        float v[8];
#pragma unroll
        for (int i = 0; i < 8; ++i) { const float cur = bf2f(up[(size_t)(8 * t8 + i) * HBW]); const float y = w0 * rm3 + w1 * rm2 + w2 * rm1 + w3 * cur + cbias; rm3 = rm2; rm2 = rm1; rm1 = cur;
            v[i] = y * sigmoidf_(y); }
        if (tid < 256) { u32x4 w; w.x = pk2(v[0], v[1]); w.y = pk2(v[2], v[3]); w.z = pk2(v[4], v[5]); w.w = pk2(v[6], v[7]); *(LAS u32x4*)(lds + SD_XT + tid * 272 + 16 * t8) = w; }
        else if (!PASS2) { u32x4 w; w.x = pk2(v[0], v[1]); w.y = pk2(v[2], v[3]); w.z = pk2(v[4], v[5]); w.w = pk2(v[6], v[7]); *(LAS u32x4*)(lds + SD_B + (tid - 256) * 272 + 16 * t8) = w; }
        else { LAS unsigned short* d = (LAS unsigned short*)(lds + (tid < 384 ? SD_B : SD_C)) + (tid < 384 ? tid - 256 : tid - 384);
#pragma unroll
            for (int i = 0; i < 8; ++i) d[(8 * t8 + i) * 136] = (unsigned short)(pk2(v[i], 0.f) & 0xffffu); }
    }
}
DI void ssd_dt(const KP& P, int L, LAS unsigned char* lds, int b, int c, int g, int tid, int lane, int wid) {
    const float* sm = (const float*)(kp_ws(P) + WS_SMALL);
    LAS float* dtS = (LAS float*)(lds + SD_DT); LAS float* acS = (LAS float*)(lds + SD_AC);
    const size_t t0 = (size_t)b * SEQ + 128 * c;
    { const int hh = tid >> 7, t = tid & 127, hg = 4 * g + hh;
      const float dtv = softplusf(sm[(t0 + t) * 16 + 4 + hg] + PIN(P, 18)[L * 8 + hg]); dtS[hh * 128 + t] = dtv; acS[hh * 128 + t] = -__expf(PIN(P, 19)[L * 8 + hg]) * dtv; }
    __syncthreads();
    if (wid < 4) { const float a0 = acS[wid * 128 + 2 * lane], a1 = acS[wid * 128 + 2 * lane + 1]; const float s = a0 + a1; float incl = s;
#pragma unroll
        for (int o = 1; o < 64; o <<= 1) { const float t = shup(incl, o, lane); if (lane >= o) incl += t; }
        const float ex = incl - s; acS[wid * 128 + 2 * lane] = ex + a0; acS[wid * 128 + 2 * lane + 1] = ex + s; }
    __syncthreads();
}
DI void ssd_pass1(const KP& P, int L, LAS unsigned char* lds, int b, int c, int g, int tid, int lane, int wid) {
    float* state = (float*)(kp_ws(P) + WS_STATE); float* atot = (float*)(kp_ws(P) + WS_MISC + MISC_ATOT);
    LAS float* dtS = (LAS float*)(lds + SD_DT); LAS float* acS = (LAS float*)(lds + SD_AC); LAS float* facS = (LAS float*)(lds + SD_FR);
    __syncthreads();
    ssd_conv<false>(P, L, lds, b, c, g, tid);
    ssd_dt(P, L, lds, b, c, g, tid, lane, wid);
    { const int hh = tid >> 7, t = tid & 127; facS[hh * 128 + t] = dtS[hh * 128 + t] * __expf(acS[hh * 128 + 127] - acS[hh * 128 + t]);
      if (t == 127) atot[((size_t)b * 64 + c) * 8 + 4 * g + hh] = acS[hh * 128 + 127]; }
    __syncthreads();
    const int hh = wid >> 1, pb = wid & 1, a = lane & 31, hi = lane >> 5;
    f32x16 acc[4];
#pragma unroll
    for (int nb = 0; nb < 4; ++nb)
#pragma unroll
        for (int r = 0; r < 16; ++r) acc[nb][r] = 0.f;
#pragma unroll 2
    for (int kc = 0; kc < 8; ++kc) {
        const u32x4 w = *(LAS const u32x4*)(lds + SD_XT + (64 * hh + 32 * pb + a) * 272 + (16 * kc + 8 * hi) * 2);
        LAS const float* fp = facS + hh * 128 + 16 * kc + 8 * hi;
        const f32x4 fa = *(LAS const f32x4*)fp, fb = *(LAS const f32x4*)(fp + 4);
        const bf16x8 af = pack8(bflo(w.x) * fa[0], bfhi(w.x) * fa[1], bflo(w.y) * fa[2], bfhi(w.y) * fa[3], bflo(w.z) * fb[0], bfhi(w.z) * fb[1], bflo(w.w) * fb[2], bfhi(w.w) * fb[3]);
#pragma unroll
        for (int nb = 0; nb < 4; ++nb) { const bf16x8 bfr = *(LAS const bf16x8*)(lds + SD_B + (32 * nb + a) * 272 + (16 * kc + 8 * hi) * 2); acc[nb] = MFMA32(af, bfr, acc[nb]); }
    }
    float* sg = state + ((((size_t)b * 64 + c) * 8 + 4 * g + hh) * 64 + 32 * pb) * 128;
#pragma unroll
    for (int nb = 0; nb < 4; ++nb)
#pragma unroll
        for (int r = 0; r < 16; ++r) sg[(size_t)crow(r, hi) * 128 + 32 * nb + a] = acc[nb][r];
}
DI void ssd_rec(const KP& P, int tid, int bxo, int Go) {
    float* state = (float*)(kp_ws(P) + WS_STATE); const float* atot = (const float*)(kp_ws(P) + WS_MISC + MISC_ATOT);
    const int NT = Go * NTH;
    for (int e = bxo * NTH + tid; e < 4 * 8 * 8192; e += NT) {
        const int b = e >> 16, hg = (e >> 13) & 7, pn = e & 8191;
        float* ptr = state + ((size_t)b * 64 * 8 + hg) * 8192 + pn; const float* at = atot + (size_t)b * 64 * 8 + hg;
        float E = 0.f;
        for (int c = 0; c < 64; c += 8) {
            float s[8], dk[8];
#pragma unroll
            for (int i = 0; i < 8; ++i) { s[i] = ptr[(size_t)(c + i) * 8 * 8192]; dk[i] = __expf(at[(c + i) * 8]); }
#pragma unroll
            for (int i = 0; i < 8; ++i) { ptr[(size_t)(c + i) * 8 * 8192] = E; E = dk[i] * E + s[i]; }
        }
    }
}
DI void ssd_pass2(const KP& P, int L, LAS unsigned char* lds, int b, int c, int g, int tid, int lane, int wid) {
    const bf16* hb = (const bf16*)(kp_ws(P) + WS_H); bf16* ycat = (bf16*)(kp_ws(P) + WS_YCAT);
    const float* state = (const float*)(kp_ws(P) + WS_STATE);
    LAS float* dtS = (LAS float*)(lds + SD_DT); LAS float* acS = (LAS float*)(lds + SD_AC); LAS float* red = (LAS float*)(lds + SD_FR);
    __syncthreads();
    ssd_conv<true>(P, L, lds, b, c, g, tid);
    ssd_dt(P, L, lds, b, c, g, tid, lane, wid);
    const int lb = wid & 3, hp = wid >> 2, a = lane & 31, hi = lane >> 5, pa = (a & 0x13) | ((a & 4) << 1) | ((a & 8) >> 1);
    const int ll = 32 * lb + a;
    const size_t t0 = (size_t)b * SEQ + 128 * c;
    f32x16 yk[2][2];
#pragma unroll
    for (int hq = 0; hq < 2; ++hq)
#pragma unroll
        for (int pb = 0; pb < 2; ++pb)
#pragma unroll
            for (int r = 0; r < 16; ++r) yk[hq][pb][r] = 0.f;
    for (int sb = 0; sb <= lb; ++sb) {
        f32x16 gt;
#pragma unroll
        for (int r = 0; r < 16; ++r) gt[r] = 0.f;
#pragma unroll 2
        for (int kc = 0; kc < 8; ++kc) {
            const bf16x8 cf = *(LAS const bf16x8*)(lds + SD_C + ll * 272 + (16 * kc + 8 * hi) * 2);
            const bf16x8 bfr = *(LAS const bf16x8*)(lds + SD_B + (32 * sb + pa) * 272 + (16 * kc + 8 * hi) * 2);
            gt = MFMA32(bfr, cf, gt);
        }
#pragma unroll
        for (int hq = 0; hq < 2; ++hq) {
            const int hh = 2 * hp + hq;
            const float acl = acS[hh * 128 + ll];
#pragma unroll
            for (int sc = 0; sc < 2; ++sc) {
                const int sbase = 32 * sb + 16 * sc + 8 * hi;
                LAS const float* ap = acS + hh * 128 + sbase; LAS const float* dp = dtS + hh * 128 + sbase;
                const f32x4 a0 = *(LAS const f32x4*)ap, a1 = *(LAS const f32x4*)(ap + 4), d0 = *(LAS const f32x4*)dp, d1 = *(LAS const f32x4*)(dp + 4);
                float mv[8];
#pragma unroll
                for (int j = 0; j < 8; ++j) { const float as = j < 4 ? a0[j & 3] : a1[j & 3], ds = j < 4 ? d0[j & 3] : d1[j & 3];
                    const float v = gt[8 * sc + j] * __expf(acl - as) * ds; mv[j] = (sbase + j <= ll) ? v : 0.f; }
                const bf16x8 mf = pack8(mv[0], mv[1], mv[2], mv[3], mv[4], mv[5], mv[6], mv[7]);
#pragma unroll
                for (int pb = 0; pb < 2; ++pb) { const bf16x8 xf = *(LAS const bf16x8*)(lds + SD_XT + (64 * hh + 32 * pb + a) * 272 + sbase * 2); yk[hq][pb] = MFMA32(xf, mf, yk[hq][pb]); }
            }
        }
    }
    float ss = 0.f;
#pragma unroll
    for (int hq = 0; hq < 2; ++hq) {
        const int hh = 2 * hp + hq, hg = 4 * g + hh;
        const float acl = acS[hh * 128 + ll];
        f32x16 yo[2];
#pragma unroll
        for (int pb = 0; pb < 2; ++pb)
#pragma unroll
            for (int r = 0; r < 16; ++r) yo[pb][r] = 0.f;
        const float* eg = state + ((((size_t)b * 64 + c) * 8 + hg) * 64) * 128;
#pragma unroll 2
        for (int kc = 0; kc < 8; ++kc) {
            const bf16x8 cf = *(LAS const bf16x8*)(lds + SD_C + ll * 272 + (16 * kc + 8 * hi) * 2);
#pragma unroll
            for (int pb = 0; pb < 2; ++pb) { const float* ep = eg + (size_t)(32 * pb + a) * 128 + 16 * kc + 8 * hi; const f32x4 e0 = *(const f32x4*)ep, e1 = *(const f32x4*)(ep + 4);
                const bf16x8 ef = pack8(e0[0], e0[1], e0[2], e0[3], e1[0], e1[1], e1[2], e1[3]); yo[pb] = MFMA32(ef, cf, yo[pb]); }
        }
        const float eal = __expf(acl), dsk = PIN(P, 20)[L * 8 + hg];
#pragma unroll
        for (int pb = 0; pb < 2; ++pb)
#pragma unroll
            for (int q4 = 0; q4 < 4; ++q4) {
                const int p0 = 32 * pb + 8 * q4 + 4 * hi;
                const u32x2 zw = *(const u32x2*)(hb + (t0 + ll) * HBW + HB_Z + 256 * g + 64 * hh + p0);
                const float zz[4] = {bflo(zw.x), bfhi(zw.x), bflo(zw.y), bfhi(zw.y)};
#pragma unroll
                for (int j = 0; j < 4; ++j) { const int r = 4 * q4 + j;
                    const float xs = bf2f(*(LAS const unsigned short*)(lds + SD_XT + (64 * hh + p0 + j) * 272 + ll * 2));
                    float y = yk[hq][pb][r] + eal * yo[pb][r] + dsk * xs; y = y * (zz[j] * sigmoidf_(zz[j])); yk[hq][pb][r] = y; ss += y * y; }
            }
    }
    ss += shx(ss, 32, lane);
    if (hi == 0) red[hp * 128 + ll] = ss;
    __syncthreads();
    const float rstd = 1.0f / sqrtf((red[ll] + red[128 + ll]) * (1.0f / 256.0f) + RMS_EPS);
    const float* ng = PIN(P, 21) + (size_t)L * 512 + 256 * g;
#pragma unroll
    for (int hq = 0; hq < 2; ++hq)
#pragma unroll
        for (int pb = 0; pb < 2; ++pb)
#pragma unroll
            for (int q4 = 0; q4 < 4; ++q4) { const int hh = 2 * hp + hq, p0 = 32 * pb + 8 * q4 + 4 * hi; const f32x4 gg = *(const f32x4*)(ng + 64 * hh + p0);
                u32x2 w; w.x = pk2(yk[hq][pb][4 * q4] * rstd * gg[0], yk[hq][pb][4 * q4 + 1] * rstd * gg[1]); w.y = pk2(yk[hq][pb][4 * q4 + 2] * rstd * gg[2], yk[hq][pb][4 * q4 + 3] * rstd * gg[3]);
                *(u32x2*)(ycat + (t0 + ll) * D + 512 + 256 * g + 64 * hh + p0) = w; }
}
#define GEMM_PHASE(EpiT, Aptr, Bptr, Nn, Kk, Eobj) do { pg8::Gemm g_{(const pg8::bf16_t*)(Aptr), (const pg8::bf16_t*)(Bptr), M, (Nn), (Kk)}; int G_o = (int)gridDim.x, c_o = (int)blockIdx.x; asm volatile("" : "+s"(G_o), "+s"(c_o)); pg8::StaticOrder S_; S_.init(M, (Nn), G_o, c_o); \
    pg8::gemm_phase<EpiT, pg8::StaticOrder, true, true>(lds, g_, S_, (Eobj), wid_s * 64 + lane_id_asm()); } while (0)

#define TID_NEW int wid_o = wid_s, bxo = (int)blockIdx.x, Go = (int)gridDim.x; asm volatile("" : "+s"(wid_o), "+s"(bxo), "+s"(Go)); const int wid = wid_o, lane = lane_id_asm(), tid = wid * 64 + lane
#define GBARK(k) do { grid_bar((unsigned*)kp_ws(P), (unsigned)(L * 13 + (k)) * (unsigned)gridDim.x, wid_s * 64 + lane_id_asm()); } while (0)
#define G Go
#define bx bxo
#define ws kp_ws(P)
#define xbA ((bf16*)(ws + WS_XBA))
#define xbB ((bf16*)(ws + WS_XBB))
#define Hb ((bf16*)(ws + WS_H))
#define sm ((float*)(ws + WS_SMALL))
#define ycat ((bf16*)(ws + WS_YCAT))
#define Pf ((float*)(ws + WS_H))
#define xo kp_out(P)

template <int L>
__device__ __forceinline__ void layer_fwd(const KP& P, LAS unsigned char* lds, const int wid_s) {
#define wl (ws + WS_W0 + (size_t)L * WS_WL)
#ifndef NO_G1
        { pg8::EpiSwiGLU E{&P}; GEMM_PHASE(pg8::EpiSwiGLU, xbA, wl + OFF_UP1, 2 * FF, D, E); }
#endif
        GBARK(1);
#ifndef NO_G2
        { pg8::EpiResid E{&P, L == 0 ? 1 : 0, 0.5f}; GEMM_PHASE(pg8::EpiResid, Hb, wl + OFF_DN1, D, FF, E); }
#endif
        GBARK(2);
#ifndef NO_LN
        { TID_NEW; ln_phase(xo, PIN(P, 2) + L * D, PIN(P, 3) + L * D, xbB, lane, wid, bxo, Go); }
#endif
        GBARK(3);
#ifndef NO_G3
        { pg8::EpiIn E{&P}; GEMM_PHASE(pg8::EpiIn, xbB, wl + OFF_WIN, NIN, D, E); }
#endif
        GBARK(4);
#ifndef NO_ATTN
        { TID_NEW; for (int u = bx; u < 256; u += G) attn_block(P, L, lds, u, tid, lane, wid);
        }
#endif
#ifndef NO_SSD1
        { TID_NEW; for (int u = bx; u < 512; u += G) ssd_pass1(P, L, lds, u >> 7, (u >> 1) & 63, u & 1, tid, lane, wid);
        }
#endif
#ifndef NO_LRU
        { TID_NEW; for (int u = bx; u < 256; u += G) lru_unit<false>(P, L, lds, u >> 6, u & 63, tid, lane, wid);
        }
#endif
        GBARK(5);
#ifndef NO_REC
        { TID_NEW; ssd_rec(P, tid, bxo, Go); lru_carry(P, tid, bxo); }
#endif
        GBARK(6);
#ifndef NO_SSD2
        { TID_NEW; for (int u = bx; u < 512; u += G) ssd_pass2(P, L, lds, u >> 7, (u >> 1) & 63, u & 1, tid, lane, wid);
        }
#endif
#ifndef NO_LRU
        { TID_NEW; for (int u = bx; u < 256; u += G) lru_unit<true>(P, L, lds, u >> 6, u & 63, tid, lane, wid);
        }
#endif
        GBARK(7);
#ifndef NO_G4
        { pg8::EpiResid E{&P, 0, 1.0f}; GEMM_PHASE(pg8::EpiResid, ycat, wl + OFF_WOUT, D, D, E); }
#endif
        GBARK(8);
#ifndef NO_LN
        { TID_NEW; ln_phase(xo, PIN(P, 23) + L * D, PIN(P, 24) + L * D, xbA, lane, wid, bxo, Go); }
#endif
        GBARK(9);
#ifndef NO_G5
        { pg8::EpiSwiGLU E{&P}; GEMM_PHASE(pg8::EpiSwiGLU, xbA, wl + OFF_UP2, 2 * FF, D, E); }
#endif
        GBARK(10);
#ifndef NO_G6
        { pg8::EpiResid E{&P, 0, 0.5f}; GEMM_PHASE(pg8::EpiResid, Hb, wl + OFF_DN2, D, FF, E); }
#endif
        GBARK(11);
#ifndef NO_LN
        { TID_NEW; ln_phase(xo, PIN(P, 28) + L * D, PIN(P, 29) + L * D, xbB, lane, wid, bxo, Go); }
#endif
#ifndef NO_G7
        { pg8::EpiF32 E{&P}; GEMM_PHASE(pg8::EpiF32, ws + WS_PB + (size_t)L * M * 256 * 2, wl + OFF_PROJ, D, 256, E); }
#endif
        GBARK(12);
#ifndef NO_G8
        { pg8::EpiPE E{&P, L}; GEMM_PHASE(pg8::EpiPE, xbB, wl + OFF_GATE, D, D, E); }
#endif
        if (L == 0) GBARK(13);
}

__global__ void __launch_bounds__(NTH, 2) hymba_fwd(KP P) {
    extern __shared__ __attribute__((aligned(16))) unsigned char lds_raw[];
    LAS unsigned char* lds = (LAS unsigned char*)lds_raw;
    cg::grid_group grid = cg::this_grid();
    const int wid_s = __builtin_amdgcn_readfirstlane((int)threadIdx.x >> 6);
#ifndef NO_PRO
    { TID_NEW; prologue(P, lds, tid, lane, wid, bxo, Go); }
#endif
    grid.sync();
    layer_fwd<0>(P, lds, wid_s);
    layer_fwd<1>(P, lds, wid_s);
}

#undef G
#undef bx
#undef ws
#undef xbA
#undef xbB
#undef Hb
#undef sm
#undef ycat
#undef Pf
#undef xo
#undef wl
extern "C" void kernel_launch(void* const* d_in, const int* in_sizes, int n_in, void* d_out, int out_size, void* d_ws, size_t ws_size, hipStream_t stream) {
    static int grid = 0;
    if (grid == 0) {
        if (n_in != 33 || out_size != M * D || ws_size < WS_END) { fprintf(stderr, "kernel_launch: unexpected shapes (n_in %d out %d ws %zu)\n", n_in, out_size, ws_size); grid = -1; return; }
        int dev = 0, cus = 0, per_cu = 0;
        (void)hipGetDevice(&dev); (void)hipDeviceGetAttribute(&cus, hipDeviceAttributeMultiprocessorCount, dev);
        if (hipFuncSetAttribute((const void*)hymba_fwd, hipFuncAttributeMaxDynamicSharedMemorySize, LDS_BYTES) != hipSuccess) { fprintf(stderr, "kernel_launch: hipFuncSetAttribute failed\n"); grid = -1; return; }
        if (hipOccupancyMaxActiveBlocksPerMultiprocessor(&per_cu, (const void*)hymba_fwd, NTH, LDS_BYTES) != hipSuccess || per_cu < 1) { fprintf(stderr, "kernel_launch: occupancy query gave %d\n", per_cu); per_cu = 1; }
        (void)hipGetLastError();
        grid = cus * 1;
        if (grid > 256) grid = 256;
    }
    if (grid < 0) return;
    if (hipMemsetAsync(d_ws, 0, 256, stream) != hipSuccess) { fprintf(stderr, "kernel_launch: memset of the barrier word failed\n"); return; }
    KP p{};
    for (int i = 0; i < 33; ++i) p.in[i] = (const float*)d_in[i];
    p.out = (float*)d_out; p.ws = (unsigned char*)d_ws;
    void* args[] = {&p};
    hipError_t e = hipLaunchCooperativeKernel((const void*)hymba_fwd, dim3(grid), dim3(NTH), args, LDS_BYTES, stream);
    if (e != hipSuccess) fprintf(stderr, "cooperative launch failed: %s (grid %d)\n", hipGetErrorString(e), grid);
}
```

```cpp
#include <hip/hip_runtime.h>
#include <hip/hip_cooperative_groups.h>
#include <cstdio>
#include <cstdint>
namespace cg = cooperative_groups;
typedef unsigned short bf16;
constexpr int M = 32768, SEQ = 8192, D = 1024, FF = 2816, NIN = 3072, HBW = 2816, NTH = 512;
constexpr int HB_U = 0, HB_G = 256, HB_Q = 512, HB_K = 768, HB_V = 1024, HB_Z = 1280, HB_X = 1792;
constexpr float ALPHA = 1.4142135623730951f, LN_EPS = 1e-5f, RMS_EPS = 1e-5f, LOG2E = 1.4426950408889634f;
constexpr size_t MiB = 1u << 20;
constexpr size_t WS_W0 = 1 * MiB, WS_WL = 44 * MiB;
constexpr size_t OFF_UP1 = 0, OFF_DN1 = 11 * MiB, OFF_WIN = 16 * MiB + MiB / 2, OFF_WOUT = 22 * MiB + MiB / 2, OFF_UP2 = 24 * MiB + MiB / 2, OFF_DN2 = 35 * MiB + MiB / 2,
                 OFF_GATE = 41 * MiB, OFF_PROJ = 43 * MiB, OFF_LRUW = 43 * MiB + MiB / 2;
constexpr size_t WS_XBA = 89 * MiB, WS_XBB = 153 * MiB, WS_H = 217 * MiB, WS_SMALL = 393 * MiB, WS_YCAT = 395 * MiB, WS_MISC = 459 * MiB, WS_PB = 460 * MiB, WS_END = 492 * MiB;
constexpr size_t WS_STATE = WS_XBA;
constexpr size_t MISC_AGG = 0, MISC_CARRY = 512 * 1024, MISC_ATOT = 768 * 1024;
constexpr int LDS_BYTES = 147456;

struct KP { const float* in[33]; float* out; unsigned char* ws; };
__device__ __forceinline__ const float* kp_in(const KP& P, int i) { asm volatile("" : "+s"(i)); return P.in[i]; }
#define PIN(P, i) kp_in((P), (i))
__device__ __forceinline__ unsigned char* kp_ws(const KP& P) { int i = 0; asm volatile("" : "+s"(i)); return *(unsigned char* const*)((const char*)&P.ws + i); }
__device__ __forceinline__ float* kp_out(const KP& P) { int i = 0; asm volatile("" : "+s"(i)); return *(float* const*)((const char*)&P.out + i); }

__device__ __forceinline__ int lane_id_asm() { int l; asm volatile("v_mbcnt_lo_u32_b32 %0, -1, 0\n\tv_mbcnt_hi_u32_b32 %0, -1, %0" : "=v"(l)); return l; }
namespace pg8 {
#define PG8_LAS __attribute__((address_space(3)))
typedef unsigned short bf16_t;
typedef short bf16x8 __attribute__((ext_vector_type(8)));
typedef float f32x4 __attribute__((ext_vector_type(4)));
typedef unsigned u32x4 __attribute__((ext_vector_type(4)));
constexpr int BM = 256, BK = 64, HALF = 128, HTB = HALF * BK * 2  , STAGE_BYTES = 8 * HTB, NXCD = 8, WGM = 8;

__host__ __device__ __forceinline__ int lds_byte(int r, int c) { const int st = (r >> 4) * 2 + (c >> 5), rr = r & 15, cc = c & 31, ob = rr * 64 + cc * 2; return st * 1024 + (ob ^ (((ob >> 9) & 1) << 5)); }
__host__ __device__ __forceinline__ void stage_rc(int b, int& R, int& C) { const int st = b / 1024, sb = b % 1024, swz = sb ^ (((sb >> 9) & 1) << 5); R = (st >> 1) * 16 + swz / 64; C = (st & 1) * 32 + (swz % 64) / 2; }
__host__ __device__ __forceinline__ int perm32(int rho) { const int n = rho >> 4, i = rho & 15; return 8 * (i >> 2) + 4 * n + (i & 3); }

struct Unit { int pm, pn; };
struct Gemm { const bf16_t* A; const bf16_t* Bt; int M, N, K; };

struct StaticOrder {
    int nM, nN, nwg, G, c;
    __host__ __device__ void init(int M, int N, int G_, int c_) { nM = M / BM; nN = N / BM; nwg = nM * nN; G = G_; c = c_; }
    __host__ __device__ bool next(int i, Unit& u) const {
        const long L = (long)i * G + c; if (L >= nwg) return false;
        int wgid = (int)L; { const int q = nwg / NXCD, r = nwg % NXCD, xcd = wgid % NXCD, off = wgid / NXCD; wgid = (xcd < r ? xcd * (q + 1) : r * (q + 1) + (xcd - r) * q) + off; }
        const int nig = WGM * nN, gid = wgid / nig, fm = gid * WGM, gsz = (nM - fm) < WGM ? (nM - fm) : WGM;
        u.pm = fm + ((wgid % nig) % gsz); u.pn = (wgid % nig) / gsz; return true;
    }
    __device__ __forceinline__ void a_ready(const Unit&) const {}
    __device__ __forceinline__ void done(const Unit&) const {}
};

__device__ __forceinline__ unsigned cvt_pk_bf16(float lo, float hi) { unsigned r; asm volatile("v_cvt_pk_bf16_f32 %0, %1, %2" : "=v"(r) : "v"(lo), "v"(hi)); return r; }
typedef float f32x2 __attribute__((ext_vector_type(2)));
typedef unsigned u32x2 __attribute__((ext_vector_type(2)));
__device__ __forceinline__ float fsigmoid(float v) { return __builtin_amdgcn_rcpf(1.0f + __expf(-v)); }
struct EpiSwiGLU {
    static constexpr bool PERM = true, AFTER_DRAIN = false;
    const KP* kp;
    __device__ __forceinline__ void operator()(const f32x4 (&acc)[2][2][4][2], const Unit& u, int wr, int wc, int fr_, int fq_) const {
        const int l_ = lane_id_asm(), fr = l_ & 15, fq = l_ >> 4;
        const int row0 = u.pm * BM + wr * 64 + fr, col0 = u.pn * HALF + wc * 32 + 8 * fq; bf16_t* H = (bf16_t*)(kp_ws(*kp) + WS_H); constexpr int ldh = FF;
#pragma unroll
        for (int ai = 0; ai < 2; ++ai)
#pragma unroll
            for (int m = 0; m < 4; ++m) {
                bf16_t* rowp = H + (size_t)(row0 + ai * HALF + m * 16) * ldh + col0;
                float o[8];
#pragma unroll
                for (int n = 0; n < 2; ++n)
#pragma unroll
                    for (int j = 0; j < 4; ++j) { const float g = acc[ai][0][m][n][j], up = acc[ai][1][m][n][j]; o[4 * n + j] = g * fsigmoid(g) * up; }
                u32x4 w; w.x = cvt_pk_bf16(o[0], o[1]); w.y = cvt_pk_bf16(o[2], o[3]); w.z = cvt_pk_bf16(o[4], o[5]); w.w = cvt_pk_bf16(o[6], o[7]);
                *(u32x4*)rowp = w;
            }
    }
};
struct EpiResid {
    static constexpr bool PERM = true, AFTER_DRAIN = false;
    const KP* kp; int first; float s;
    __device__ __forceinline__ void operator()(const f32x4 (&acc)[2][2][4][2], const Unit& u, int wr, int wc, int fr_, int fq_) const {
        const int l_ = lane_id_asm(), fr = l_ & 15, fq = l_ >> 4;
        const int row0 = u.pm * BM + wr * 64 + fr, col0 = u.pn * BM + wc * 32 + 8 * fq; float* out = kp_out(*kp); const float* res = first ? kp_in(*kp, 0) : (const float*)out; constexpr float alpha = ALPHA;
#pragma unroll
        for (int ai = 0; ai < 2; ++ai)
#pragma unroll
            for (int m = 0; m < 4; ++m) {
                const size_t off = (size_t)(row0 + ai * HALF + m * 16) * 1024 + col0;
#pragma unroll
                for (int bj = 0; bj < 2; ++bj) {
                    const f32x4 r0 = *(const f32x4*)(res + off + bj * HALF), r1 = *(const f32x4*)(res + off + bj * HALF + 4);
                    const f32x4 o0 = r0 * alpha + acc[ai][bj][m][0] * s, o1 = r1 * alpha + acc[ai][bj][m][1] * s;
                    *(f32x4*)(out + off + bj * HALF) = o0; *(f32x4*)(out + off + bj * HALF + 4) = o1;
                }
                asm volatile("" ::: "memory");
            }
    }
};
struct EpiIn {
    static constexpr bool PERM = true, AFTER_DRAIN = false;
    const KP* kp;
    __device__ __forceinline__ void operator()(const f32x4 (&acc)[2][2][4][2], const Unit& u, int wr, int wc, int fr_, int fq_) const {
        const int l_ = lane_id_asm(), fr = l_ & 15, fq = l_ >> 4;
        const int row0 = u.pm * BM + wr * 64 + fr; bf16_t* hb = (bf16_t*)(kp_ws(*kp) + WS_H); float* sm = (float*)(kp_ws(*kp) + WS_SMALL);
        if (u.pn < 11) {
            const int col0 = u.pn * BM + wc * 32 + 8 * fq;
#pragma unroll
            for (int ai = 0; ai < 2; ++ai)
#pragma unroll
                for (int m = 0; m < 4; ++m) {
                    bf16_t* rowp = hb + (size_t)(row0 + ai * HALF + m * 16) * 2816 + col0;
#pragma unroll
                    for (int bj = 0; bj < 2; ++bj) { const f32x4 v0 = acc[ai][bj][m][0], v1 = acc[ai][bj][m][1];
                        u32x4 w; w.x = cvt_pk_bf16(v0[0], v0[1]); w.y = cvt_pk_bf16(v0[2], v0[3]); w.z = cvt_pk_bf16(v1[0], v1[1]); w.w = cvt_pk_bf16(v1[2], v1[3]);
                        *(u32x4*)(rowp + bj * HALF) = w; }
                }
        } else if (wc == 0 && fq < 2) {
#pragma unroll
            for (int ai = 0; ai < 2; ++ai)
#pragma unroll
                for (int m = 0; m < 4; ++m) {
                    float* p = sm + (size_t)(row0 + ai * HALF + m * 16) * 16 + 8 * fq;
                    *(f32x4*)p = acc[ai][0][m][0]; *(f32x4*)(p + 4) = acc[ai][0][m][1];
                }
        }
    }
};
struct EpiF32 {
    static constexpr bool PERM = true, AFTER_DRAIN = false;
    const KP* kp;
    __device__ __forceinline__ void operator()(const f32x4 (&acc)[2][2][4][2], const Unit& u, int wr, int wc, int fr_, int fq_) const {
        const int l_ = lane_id_asm(), fr = l_ & 15, fq = l_ >> 4;
        const int row0 = u.pm * BM + wr * 64 + fr, col0 = u.pn * BM + wc * 32 + 8 * fq; float* O = (float*)(kp_ws(*kp) + WS_H);
#pragma unroll
        for (int ai = 0; ai < 2; ++ai)
#pragma unroll
            for (int m = 0; m < 4; ++m) {
                const size_t off = (size_t)(row0 + ai * HALF + m * 16) * 1024 + col0;
#pragma unroll
                for (int bj = 0; bj < 2; ++bj) { *(f32x4*)(O + off + bj * HALF) = acc[ai][bj][m][0]; *(f32x4*)(O + off + bj * HALF + 4) = acc[ai][bj][m][1]; }
            }
    }
};
struct EpiPE {
    static constexpr bool PERM = true, AFTER_DRAIN = false;
    const KP* kp; int L;
    __device__ __forceinline__ void operator()(const f32x4 (&acc)[2][2][4][2], const Unit& u, int wr, int wc, int fr_, int fq_) const {
        const int l_ = lane_id_asm(), fr = l_ & 15, fq = l_ >> 4;
        const int row0 = u.pm * BM + wr * 64 + fr, col0 = u.pn * BM + wc * 32 + 8 * fq;
        float* x = kp_out(*kp); const float* P = (const float*)(kp_ws(*kp) + WS_H); const float* bias = kp_in(*kp, 32) + L * D; bf16_t* xb = (bf16_t*)(kp_ws(*kp) + WS_XBA);
#pragma unroll
        for (int ai = 0; ai < 2; ++ai)
#pragma unroll
            for (int m = 0; m < 4; ++m) {
                const size_t off = (size_t)(row0 + ai * HALF + m * 16) * 1024 + col0;
#pragma unroll
                for (int bj = 0; bj < 2; ++bj) {
                    f32x4 o[2];
#pragma unroll
                    for (int n = 0; n < 2; ++n) {
                        const f32x4 xv = *(const f32x4*)(x + off + bj * HALF + 4 * n), pv = *(const f32x4*)(P + off + bj * HALF + 4 * n), bv = *(const f32x4*)(bias + col0 + bj * HALF + 4 * n);
                        const f32x4 g = acc[ai][bj][m][n] + bv;
                        f32x4 r; r[0] = xv[0] + fsigmoid(g[0]) * pv[0]; r[1] = xv[1] + fsigmoid(g[1]) * pv[1]; r[2] = xv[2] + fsigmoid(g[2]) * pv[2]; r[3] = xv[3] + fsigmoid(g[3]) * pv[3];
                        o[n] = r; *(f32x4*)(x + off + bj * HALF + 4 * n) = r;
                    }
                    u32x4 w; w.x = cvt_pk_bf16(o[0][0], o[0][1]); w.y = cvt_pk_bf16(o[0][2], o[0][3]); w.z = cvt_pk_bf16(o[1][0], o[1][1]); w.w = cvt_pk_bf16(o[1][2], o[1][3]);
                    *(u32x4*)(xb + off + bj * HALF) = w;
                    asm volatile("" ::: "memory");
                }
            }
    }
};
template <class Epi, class Sched, bool ALIGN_EPI = false, bool SP2 = false>
__device__ __forceinline__ void gemm_phase(PG8_LAS unsigned char* lds, const Gemm g, const Sched& S, const Epi& E, int tid_in) {
    int tid_o = tid_in; asm volatile("" : "+v"(tid_o));
    const int tid = tid_o, wid = __builtin_amdgcn_readfirstlane(tid >> 6), lane = tid & 63, wr = wid >> 2, wc = wid & 3, fr = lane & 15, fq = lane >> 4;
    const int K = g.K, nt = K / BK;
    unsigned voffA[2], voffB[2];
#pragma unroll
    for (int i = 0; i < 2; ++i) { int R, C; stage_rc(tid * 16 + i * 8192, R, C); const int Rb = Epi::PERM ? ((R & ~31) + perm32(R & 31)) : R;
        voffA[i] = (unsigned)(R * K + C) * 2u; voffB[i] = (unsigned)(Rb * K + C) * 2u; }
    const size_t kstep = (size_t)(BK * 2);
    const size_t hstep = (size_t)HALF * K * 2;
    const size_t tstep = 2 * hstep;
    const unsigned ldsw = (unsigned)wid * 1024u;
    const int aoff = lds_byte(wr * 64 + fr, fq * 8), boff = lds_byte(wc * 32 + fr, fq * 8);
#define PG8_SA(b, h) (((b) * 2 + (h)) * HTB)
#define PG8_SB(b, h) ((4 + (b) * 2 + (h)) * HTB)
#define PG8_STAGE(bufoff, gbase, voff) do { _Pragma("unroll") for (int _i = 0; _i < 2; ++_i) \
        __builtin_amdgcn_global_load_lds((const unsigned*)((const char*)(gbase) + (voff)[_i]), (PG8_LAS unsigned*)(lds + (bufoff) + ldsw + _i * 8192), 16, 0, 0); } while (0)
#define PG8_LDA(dst, b, h) do { _Pragma("unroll") for (int m = 0; m < 4; ++m) _Pragma("unroll") for (int k = 0; k < 2; ++k) dst[m][k] = *(const PG8_LAS bf16x8*)(lds + PG8_SA(b, h) + aoff + m * 2048 + k * 1024); } while (0)
#define PG8_LDB(dst, b, h) do { _Pragma("unroll") for (int n = 0; n < 2; ++n) _Pragma("unroll") for (int k = 0; k < 2; ++k) dst[n][k] = *(const PG8_LAS bf16x8*)(lds + PG8_SB(b, h) + boff + n * 2048 + k * 1024); } while (0)
#define PG8_MMA(ai, bj, At, Bt) do { __builtin_amdgcn_s_setprio(1); _Pragma("unroll") for (int m = 0; m < 4; ++m) _Pragma("unroll") for (int n = 0; n < 2; ++n) _Pragma("unroll") for (int k = 0; k < 2; ++k) \
        acc[ai][bj][m][n] = __builtin_amdgcn_mfma_f32_16x16x32_bf16(Bt[n][k], At[m][k], acc[ai][bj][m][n], 0, 0, 0); __builtin_amdgcn_s_setprio(0); } while (0)
#define PG8_WAIT_V(n) asm volatile("s_waitcnt vmcnt(" #n ")" ::: "memory")
#define PG8_WAIT_L(n) asm volatile("s_waitcnt lgkmcnt(" #n ")" ::: "memory")
#define PG8_BAR __builtin_amdgcn_s_barrier()
#define PG8_SCHED __builtin_amdgcn_sched_barrier(0)
    Unit cur, nxt; int ui = 0;
    if (!S.next(0, cur)) return;
    f32x4 acc[2][2][4][2];
#pragma unroll
    for (int a = 0; a < 2; ++a)
#pragma unroll
        for (int b = 0; b < 2; ++b)
#pragma unroll
            for (int m = 0; m < 4; ++m)
#pragma unroll
                for (int n = 0; n < 2; ++n) acc[a][b][m][n] = (f32x4){0.f, 0.f, 0.f, 0.f};
    bf16x8 At[4][2], B0[2][2], B1[2][2];
    const char* cA = (const char*)g.A + (size_t)cur.pm * tstep; const char* cB = (const char*)g.Bt + (size_t)cur.pn * tstep;
    S.a_ready(cur);
    if constexpr (SP2) {
        PG8_STAGE(PG8_SB(0, 0), cB, voffB); PG8_STAGE(PG8_SB(0, 1), cB + hstep, voffB); PG8_STAGE(PG8_SA(0, 0), cA, voffA); PG8_STAGE(PG8_SA(0, 1), cA + hstep, voffA);
        if (wr == 1) PG8_BAR;
        PG8_WAIT_V(2); PG8_BAR;
        PG8_STAGE(PG8_SB(1, 0), cB + kstep, voffB); PG8_STAGE(PG8_SA(1, 0), cA + kstep, voffA); PG8_STAGE(PG8_SB(1, 1), cB + hstep + kstep, voffB);
        PG8_WAIT_V(6); PG8_BAR;
    } else {
        PG8_STAGE(PG8_SB(0, 0), cB, voffB); PG8_STAGE(PG8_SA(0, 0), cA, voffA); PG8_STAGE(PG8_SB(0, 1), cB + hstep, voffB); PG8_STAGE(PG8_SA(0, 1), cA + hstep, voffA);
        if (wr == 1) PG8_BAR;
        PG8_WAIT_V(4); PG8_BAR;
        PG8_STAGE(PG8_SB(1, 0), cB + kstep, voffB); PG8_STAGE(PG8_SA(1, 0), cA + kstep, voffA); PG8_STAGE(PG8_SB(1, 1), cB + hstep + kstep, voffB);
        PG8_WAIT_V(6); PG8_BAR;
    }
    for (;;) {
        const bool has_next = S.next(ui + 1, nxt);
        const char* nA = has_next ? (const char*)g.A + (size_t)nxt.pm * tstep : cA; const char* nB = has_next ? (const char*)g.Bt + (size_t)nxt.pn * tstep : cB;
        for (int t = 0; t < nt; t += 2) {
            const bool last = (t == nt - 2);
            const char* a1 = cA + (size_t)(t + 1) * kstep;
            const char* a2 = last ? nA : cA + (size_t)(t + 2) * kstep; const char* b2 = last ? nB : cB + (size_t)(t + 2) * kstep;
            const char* a3 = a2 + kstep; const char* b3 = b2 + kstep;
            if (last && has_next) S.a_ready(nxt);
            if constexpr (SP2) {
            PG8_LDB(B0, 0, 0); PG8_LDB(B1, 0, 1); PG8_SCHED; PG8_LDA(At, 0, 0); PG8_STAGE(PG8_SA(1, 1), a1 + hstep, voffA);
            PG8_WAIT_V(8); PG8_WAIT_L(0); PG8_BAR; PG8_MMA(0, 0, At, B0); PG8_MMA(0, 1, At, B1); PG8_BAR; PG8_SCHED;
            PG8_LDA(At, 0, 1); PG8_STAGE(PG8_SB(0, 0), b2, voffB); PG8_STAGE(PG8_SB(0, 1), b2 + hstep, voffB); PG8_STAGE(PG8_SA(0, 0), a2, voffA);
            PG8_WAIT_V(8); PG8_WAIT_L(0); PG8_BAR; PG8_MMA(1, 0, At, B0); PG8_MMA(1, 1, At, B1); PG8_BAR; PG8_SCHED;
            PG8_LDB(B0, 1, 0); PG8_LDB(B1, 1, 1); PG8_SCHED; PG8_LDA(At, 1, 0); PG8_STAGE(PG8_SA(0, 1), a2 + hstep, voffA);
            PG8_WAIT_V(8); PG8_WAIT_L(0); PG8_BAR; PG8_MMA(0, 0, At, B0); PG8_MMA(0, 1, At, B1); PG8_BAR; PG8_SCHED;
            PG8_LDA(At, 1, 1); PG8_STAGE(PG8_SB(1, 0), b3, voffB); PG8_STAGE(PG8_SB(1, 1), b3 + hstep, voffB); PG8_STAGE(PG8_SA(1, 0), a3, voffA);
            PG8_WAIT_V(8); PG8_WAIT_L(0); PG8_BAR; PG8_MMA(1, 0, At, B0); PG8_MMA(1, 1, At, B1); PG8_BAR; PG8_SCHED;
            } else {
            PG8_LDB(B0, 0, 0); PG8_SCHED; PG8_LDA(At, 0, 0); PG8_STAGE(PG8_SA(1, 1), a1 + hstep, voffA);
            PG8_WAIT_L(8); PG8_BAR; PG8_WAIT_L(0); PG8_MMA(0, 0, At, B0); PG8_BAR; PG8_SCHED;
            PG8_LDB(B1, 0, 1); PG8_STAGE(PG8_SB(0, 0), b2, voffB);
            PG8_BAR; PG8_WAIT_L(0); PG8_MMA(0, 1, At, B1); PG8_BAR;
            PG8_LDA(At, 0, 1); PG8_STAGE(PG8_SA(0, 0), a2, voffA);
            PG8_BAR; PG8_WAIT_L(0); PG8_MMA(1, 0, At, B0); PG8_BAR; PG8_SCHED;
            PG8_STAGE(PG8_SB(0, 1), b2 + hstep, voffB);
            PG8_WAIT_V(6); PG8_BAR; PG8_MMA(1, 1, At, B1); PG8_BAR;
            PG8_LDB(B0, 1, 0); PG8_SCHED; PG8_LDA(At, 1, 0); PG8_STAGE(PG8_SA(0, 1), a2 + hstep, voffA);
            PG8_WAIT_L(8); PG8_BAR; PG8_WAIT_L(0); PG8_MMA(0, 0, At, B0); PG8_BAR; PG8_SCHED;
            PG8_LDB(B1, 1, 1); PG8_STAGE(PG8_SB(1, 0), b3, voffB);
            PG8_BAR; PG8_WAIT_L(0); PG8_MMA(0, 1, At, B1); PG8_BAR;
            PG8_LDA(At, 1, 1); PG8_STAGE(PG8_SA(1, 0), a3, voffA);
            PG8_BAR; PG8_WAIT_L(0); PG8_MMA(1, 0, At, B0); PG8_BAR; PG8_SCHED;
            PG8_STAGE(PG8_SB(1, 1), b3 + hstep, voffB);
            PG8_WAIT_V(6); PG8_BAR; PG8_MMA(1, 1, At, B1); PG8_BAR;
            }
        }
        if constexpr (ALIGN_EPI) { if (wr == 0) PG8_BAR; }
        if constexpr (!Epi::AFTER_DRAIN) { E(acc, cur, wr, wc, fr, fq); S.done(cur); }
        if (!has_next) break;
#pragma unroll
        for (int a = 0; a < 2; ++a)
#pragma unroll
            for (int b = 0; b < 2; ++b)
#pragma unroll
                for (int m = 0; m < 4; ++m)
#pragma unroll
                    for (int n = 0; n < 2; ++n) acc[a][b][m][n] = (f32x4){0.f, 0.f, 0.f, 0.f};
        cur = nxt; cA = nA; cB = nB; ++ui;
        if constexpr (ALIGN_EPI) { if (wr == 1) PG8_BAR; }
    }
    PG8_WAIT_V(0);
    if constexpr (!ALIGN_EPI) { if (wr == 0) PG8_BAR; }
    PG8_BAR;
    if constexpr (Epi::AFTER_DRAIN) { E.fused(acc, cur, wr, wc, fr, fq, lds, wid, lane); S.done(cur); }
#undef PG8_SA
#undef PG8_SB
#undef PG8_STAGE
#undef PG8_LDA
#undef PG8_LDB
#undef PG8_MMA
#undef PG8_WAIT_V
#undef PG8_WAIT_L
#undef PG8_BAR
#undef PG8_SCHED
}
}
#define LAS __attribute__((address_space(3)))
#define DI __device__ __forceinline__
typedef short bf16x8 __attribute__((ext_vector_type(8)));
typedef float f32x4 __attribute__((ext_vector_type(4)));
typedef float f32x16 __attribute__((ext_vector_type(16)));
typedef unsigned u32x4 __attribute__((ext_vector_type(4)));
typedef unsigned u32x2 __attribute__((ext_vector_type(2)));
typedef float f32x2_t __attribute__((ext_vector_type(2)));
typedef __bf16 bf16x2_t __attribute__((ext_vector_type(2)));
#define MFMA32(a, b, c) __builtin_amdgcn_mfma_f32_32x32x16_bf16((a), (b), (c), 0, 0, 0)

DI unsigned pk2(float lo, float hi) { f32x2_t v = {lo, hi}; bf16x2_t b = __builtin_convertvector(v, bf16x2_t); return __builtin_bit_cast(unsigned, b); }
DI float bf2f(unsigned short b) { return __uint_as_float((unsigned)b << 16); }
DI float bflo(unsigned w) { return __uint_as_float(w << 16); }
DI float bfhi(unsigned w) { return __uint_as_float(w & 0xffff0000u); }
DI void grid_bar(unsigned* ctr, unsigned target, int tid) {
    asm volatile("s_waitcnt vmcnt(0)" ::: "memory");
    __syncthreads();
    if (tid == 0) {
        __builtin_amdgcn_fence(__ATOMIC_RELEASE, "agent");
        asm volatile("s_waitcnt vmcnt(0)" ::: "memory");
        __hip_atomic_fetch_add(ctr, 1u, __ATOMIC_RELAXED, __HIP_MEMORY_SCOPE_AGENT);
        while (__hip_atomic_load(ctr, __ATOMIC_RELAXED, __HIP_MEMORY_SCOPE_AGENT) < target) __builtin_amdgcn_s_sleep(2);
        __builtin_amdgcn_fence(__ATOMIC_ACQUIRE, "agent");
        asm volatile("s_waitcnt vmcnt(0)" ::: "memory");
    }
    __syncthreads();
}
DI float shx(float v, int mask, int lane) { return __builtin_bit_cast(float, __builtin_amdgcn_ds_bpermute((lane ^ mask) << 2, __builtin_bit_cast(int, v))); }
DI float shup(float v, int o, int lane) { return __builtin_bit_cast(float, __builtin_amdgcn_ds_bpermute(((lane - o) & 63) << 2, __builtin_bit_cast(int, v))); }
DI float wave_sum(float v, int lane) {
#pragma unroll
    for (int o = 1; o < 64; o <<= 1) v += shx(v, o, lane);
    return v;
}
DI float bfsel(const u32x4& w, int j) { const unsigned x = (j >> 1) == 0 ? w.x : ((j >> 1) == 1 ? w.y : ((j >> 1) == 2 ? w.z : w.w)); return (j & 1) ? bfhi(x) : bflo(x); }
DI float softplusf(float v) { return fmaxf(v, 0.f) + log1pf(__expf(-fabsf(v))); }
DI float sigmoidf_(float v) { return 1.0f / (1.0f + __expf(-v)); }
DI int crow(int r, int hi) { return (r & 3) + 8 * (r >> 2) + 4 * hi; }
DI bf16x8 pack8(float a0, float a1, float a2, float a3, float a4, float a5, float a6, float a7) {
    u32x4 w; w.x = pk2(a0, a1); w.y = pk2(a2, a3); w.z = pk2(a4, a5); w.w = pk2(a6, a7); return __builtin_bit_cast(bf16x8, w);
}

DI void transpose_item(const float* W, int K, int N, bf16* WT, int mode, LAS float* scr, int item, int lane) {
    const int nblk = N / 32, kb = item / nblk, nb = item % nblk, k0 = 64 * kb, n0 = 32 * nb;
#pragma unroll 8
    for (int i = 0; i < 32; ++i) { const int kk = 2 * i + (lane >> 5); scr[kk * 33 + (lane & 31)] = W[(size_t)(k0 + kk) * N + n0 + (lane & 31)]; }
    asm volatile("s_waitcnt lgkmcnt(0)" ::: "memory");
    const int c = lane & 7;
    const int rbase = (mode == 0) ? n0 : (256 * (n0 >> 7) + (n0 & 127) + (mode == 2 ? 128 : 0));
#pragma unroll
    for (int j = 0; j < 4; ++j) { const int n = (lane >> 3) + 8 * j; const LAS float* s = scr + (8 * c) * 33 + n;
        u32x4 o; o.x = pk2(s[0 * 33], s[1 * 33]); o.y = pk2(s[2 * 33], s[3 * 33]); o.z = pk2(s[4 * 33], s[5 * 33]); o.w = pk2(s[6 * 33], s[7 * 33]);
        *(u32x4*)(WT + (size_t)(rbase + n) * K + k0 + 8 * c) = o; }
    asm volatile("s_waitcnt lgkmcnt(0)" ::: "memory");
}
DI int win_src(int n) { return n < 1280 ? n : (n < 2816 ? n + 4 : (n < 2820 ? 1280 + (n - 2816) : (n < 2828 ? n : -1))); }

DI void prologue(const KP& P, LAS unsigned char* lds, int tid, int lane, int wid, int bxo, int Go) {
    LAS float* scr = (LAS float*)(lds + wid * 16384);
    const int gw = bxo * 8 + wid, NGW = Go * 8;
    const size_t gt = (size_t)bxo * NTH + tid, NGT = (size_t)Go * NTH;
    constexpr int I_UP = 16 * 88, I_DN = 44 * 32, I_SQ = 16 * 32, I_PR = 4 * 32, I_WIN = 384 * 16;
    constexpr int PER = 4 * I_UP + 2 * I_DN + 2 * I_SQ + I_PR + I_WIN;
    for (int it = gw; it < 2 * PER; it += NGW) {
        const int L = it / PER; int r = it % PER;
        unsigned char* wl = kp_ws(P) + WS_W0 + (size_t)L * WS_WL;
        if (r < I_UP) { transpose_item(PIN(P, 4) + (size_t)L * D * FF, D, FF, (bf16*)(wl + OFF_UP1), 1, scr, r, lane); continue; } r -= I_UP;
        if (r < I_UP) { transpose_item(PIN(P, 5) + (size_t)L * D * FF, D, FF, (bf16*)(wl + OFF_UP1), 2, scr, r, lane); continue; } r -= I_UP;
        if (r < I_DN) { transpose_item(PIN(P, 6) + (size_t)L * D * FF, FF, D, (bf16*)(wl + OFF_DN1), 0, scr, r, lane); continue; } r -= I_DN;
        if (r < I_SQ) { transpose_item(PIN(P, 22) + (size_t)L * D * D, D, D, (bf16*)(wl + OFF_WOUT), 0, scr, r, lane); continue; } r -= I_SQ;
        if (r < I_UP) { transpose_item(PIN(P, 25) + (size_t)L * D * FF, D, FF, (bf16*)(wl + OFF_UP2), 1, scr, r, lane); continue; } r -= I_UP;
        if (r < I_UP) { transpose_item(PIN(P, 26) + (size_t)L * D * FF, D, FF, (bf16*)(wl + OFF_UP2), 2, scr, r, lane); continue; } r -= I_UP;
        if (r < I_DN) { transpose_item(PIN(P, 27) + (size_t)L * D * FF, FF, D, (bf16*)(wl + OFF_DN2), 0, scr, r, lane); continue; } r -= I_DN;
        if (r < I_SQ) { transpose_item(PIN(P, 31) + (size_t)L * D * D, D, D, (bf16*)(wl + OFF_GATE), 0, scr, r, lane); continue; } r -= I_SQ;
        if (r < I_PR) { transpose_item(PIN(P, 30) + (size_t)L * 256 * D, 256, D, (bf16*)(wl + OFF_PROJ), 0, scr, r, lane); continue; } r -= I_PR;
        {
            const float* W = PIN(P, 7) + (size_t)L * D * 2828; bf16* WT = (bf16*)(wl + OFF_WIN);
            const int n = 8 * (r / 16) + (lane >> 3), kc = 8 * (r % 16) + (lane & 7), src = win_src(n);
            float v[8];
#pragma unroll
            for (int i = 0; i < 8; ++i) v[i] = (src >= 0) ? W[(size_t)(8 * kc + i) * 2828 + src] : 0.f;
            u32x4 o; o.x = pk2(v[0], v[1]); o.y = pk2(v[2], v[3]); o.z = pk2(v[4], v[5]); o.w = pk2(v[6], v[7]);
            *(u32x4*)(WT + (size_t)n * D + 8 * kc) = o;
        }
    }
    for (size_t e = gt; e < 2 * 2 * 16384; e += NGT) {
        const int L = (int)(e >> 15), which = (int)(e >> 14) & 1, idx = (int)(e & 16383), h = idx >> 12, n = (idx >> 6) & 63, k = idx & 63;
        const float* s10 = PIN(P, 10); const float* s12 = PIN(P, 12); const float* src = (which ? s12 : s10) + (size_t)L * 16384;
        bf16* dst = (bf16*)(kp_ws(P) + WS_W0 + (size_t)L * WS_WL + OFF_LRUW) + which * 16384;
        dst[idx] = (bf16)(pk2(src[(h * 64 + k) * 64 + n], 0.f) & 0xffffu);
    }
    {
        const f32x4* x4 = (const f32x4*)PIN(P, 0); u32x4* o = (u32x4*)(kp_ws(P) + WS_XBA);
        for (size_t e = gt; e < (size_t)M * D / 8; e += NGT) { const f32x4 a = x4[2 * e], b = x4[2 * e + 1]; u32x4 w; w.x = pk2(a[0], a[1]); w.y = pk2(a[2], a[3]); w.z = pk2(b[0], b[1]); w.w = pk2(b[2], b[3]); o[e] = w; }
        const f32x4* p4 = (const f32x4*)PIN(P, 1); u32x4* po = (u32x4*)(kp_ws(P) + WS_PB);
        for (size_t e = gt; e < (size_t)2 * M * 256 / 8; e += NGT) { const f32x4 a = p4[2 * e], b = p4[2 * e + 1]; u32x4 w; w.x = pk2(a[0], a[1]); w.y = pk2(a[2], a[3]); w.z = pk2(b[0], b[1]); w.w = pk2(b[2], b[3]); po[e] = w; }
    }
}

DI void ln_phase(float* x, const float* g, const float* bta, bf16* xb, int lane, int wid, int bxo, int Go) {
    const int gw = bxo * 8 + wid, NGW = Go * 8;
    for (int m = gw; m < M; m += NGW) {
        f32x4* xr = (f32x4*)(x + (size_t)m * D) + lane;
        f32x4 v[4]; float s = 0.f;
#pragma unroll
        for (int j = 0; j < 4; ++j) { v[j] = xr[64 * j]; s += (v[j][0] + v[j][1]) + (v[j][2] + v[j][3]); }
        const float mean = wave_sum(s, lane) * (1.f / D); float s2 = 0.f;
#pragma unroll
        for (int j = 0; j < 4; ++j) { v[j] = v[j] - mean; s2 += (v[j][0] * v[j][0] + v[j][1] * v[j][1]) + (v[j][2] * v[j][2] + v[j][3] * v[j][3]); }
        const float rstd = 1.f / sqrtf(wave_sum(s2, lane) * (1.f / D) + LN_EPS);
        u32x2* o8 = (u32x2*)(xb + (size_t)m * D) + lane;
#pragma unroll
        for (int j = 0; j < 4; ++j) {
            const f32x4 gg = ((const f32x4*)g)[lane + 64 * j], bb = ((const f32x4*)bta)[lane + 64 * j];
            const f32x4 o = v[j] * rstd * gg + bb; xr[64 * j] = o;
            u32x2 w; w.x = pk2(o[0], o[1]); w.y = pk2(o[2], o[3]); o8[64 * j] = w;
        }
    }
}
constexpr int AT_KV = 32768, AT_TILE = 9216, AT_RED = AT_KV + 4 * AT_TILE;
DI void attn_unit(const bf16* hb, bf16* ycat, LAS unsigned char* lds, int b, int h, int qb, int tid, int lane, int wid) {
    LAS const float* Fs = (LAS const float*)lds;
    const int q0 = 256 * qb + 32 * wid, qi = lane & 31, hi = lane >> 5;
    const size_t rowbase = (size_t)b * SEQ;
    constexpr float C2 = 0.125f * LOG2E;
    bf16x8 qf[4];
    {
        const bf16* qp = hb + (rowbase + q0 + qi) * HBW + HB_Q + 64 * h + 8 * hi;
#pragma unroll
        for (int d0 = 0; d0 < 4; ++d0) { const u32x4 w = *(const u32x4*)(qp + 16 * d0);
            qf[d0] = pack8(bflo(w.x) * C2, bfhi(w.x) * C2, bflo(w.y) * C2, bfhi(w.y) * C2, bflo(w.z) * C2, bfhi(w.z) * C2, bflo(w.w) * C2, bfhi(w.w) * C2); }
    }
    const float fq2 = Fs[q0 + qi];
    float mrun = -1e30f, lrun = 0.f;
    f32x16 ot0, ot1;
#pragma unroll
    for (int r = 0; r < 16; ++r) { ot0[r] = 0.f; ot1[r] = 0.f; }
    const int ntiles = 4 * (qb + 1);
    const int krow = tid >> 3, kch = tid & 7, vrow = tid & 63, vch = tid >> 6;
    const bf16* kg = hb + (rowbase + krow) * HBW + HB_K + 64 * h + 8 * kch;
    const bf16* vg = hb + (rowbase + vrow) * HBW + HB_V + 64 * h + 8 * vch;
    u32x4 kreg = *(const u32x4*)(kg + (size_t)(ntiles - 1) * 64 * HBW), vreg = *(const u32x4*)(vg + (size_t)(ntiles - 1) * 64 * HBW);
    const int a = lane & 31, pa = (a & 0x13) | ((a & 4) << 1) | ((a & 8) >> 1);
    __syncthreads();
#define AT_STORE(buf) do { LAS unsigned char* Kb_ = lds + AT_KV + (buf) * AT_TILE; LAS unsigned char* Vb_ = lds + AT_KV + 2 * AT_TILE + (buf) * AT_TILE; \
        *(LAS u32x4*)(Kb_ + krow * 144 + 16 * kch) = kreg; \
        LAS unsigned short* vp_ = (LAS unsigned short*)(Vb_ + (8 * vch) * 144 + 2 * vrow); \
        vp_[0 * 72] = (unsigned short)(vreg.x & 0xffffu); vp_[1 * 72] = (unsigned short)(vreg.x >> 16); vp_[2 * 72] = (unsigned short)(vreg.y & 0xffffu); vp_[3 * 72] = (unsigned short)(vreg.y >> 16); \
        vp_[4 * 72] = (unsigned short)(vreg.z & 0xffffu); vp_[5 * 72] = (unsigned short)(vreg.z >> 16); vp_[6 * 72] = (unsigned short)(vreg.w & 0xffffu); vp_[7 * 72] = (unsigned short)(vreg.w >> 16); } while (0)
    AT_STORE(0);
    __syncthreads();
    for (int it = 0; it < ntiles; ++it) {
        const int jt = ntiles - 1 - it, buf = it & 1;
        if (it + 1 < ntiles) { kreg = *(const u32x4*)(kg + (size_t)(jt - 1) * 64 * HBW); vreg = *(const u32x4*)(vg + (size_t)(jt - 1) * 64 * HBW); }
        if (64 * jt <= q0 + 31) {
            LAS const unsigned char* Kb = lds + AT_KV + buf * AT_TILE; LAS const unsigned char* Vb = lds + AT_KV + 2 * AT_TILE + buf * AT_TILE;
            f32x16 sp[2];
#pragma unroll
            for (int p = 0; p < 2; ++p) {
                LAS const float* fk = Fs + 64 * jt + 32 * p + 8 * hi;
                const f32x4 f0 = *(LAS const f32x4*)fk, f1 = *(LAS const f32x4*)(fk + 4), f2 = *(LAS const f32x4*)(fk + 16), f3 = *(LAS const f32x4*)(fk + 20);
#pragma unroll
                for (int j = 0; j < 4; ++j) { sp[p][j] = fq2 - f0[j]; sp[p][4 + j] = fq2 - f1[j]; sp[p][8 + j] = fq2 - f2[j]; sp[p][12 + j] = fq2 - f3[j]; }
#pragma unroll
                for (int d0 = 0; d0 < 4; ++d0) {
                    const bf16x8 kf = *(LAS const bf16x8*)(Kb + (32 * p + pa) * 144 + (16 * d0 + 8 * hi) * 2);
                    sp[p] = MFMA32(kf, qf[d0], sp[p]);
                }
            }
            if (64 * jt + 63 > q0) {
                const int qabs = q0 + qi;
#pragma unroll
                for (int p = 0; p < 2; ++p)
#pragma unroll
                    for (int r = 0; r < 16; ++r) { const int kv = 64 * jt + 32 * p + 16 * (r >> 3) + 8 * hi + (r & 7); if (kv > qabs) sp[p][r] = -1e30f; }
            }
            float mx = sp[0][0];
#pragma unroll
            for (int r = 1; r < 16; ++r) mx = fmaxf(mx, sp[0][r]);
#pragma unroll
            for (int r = 0; r < 16; ++r) mx = fmaxf(mx, sp[1][r]);
            mx = fmaxf(mx, shx(mx, 32, lane));
            if (__builtin_amdgcn_ballot_w64(mx >= mrun - 40.0f) != 0ull) {
            const float mn = fmaxf(mrun, mx), alpha = __builtin_amdgcn_exp2f(mrun - mn);
            mrun = mn;
            float ls = 0.f;
#pragma unroll
            for (int p = 0; p < 2; ++p)
#pragma unroll
                for (int r = 0; r < 16; ++r) { const float e = __builtin_amdgcn_exp2f(sp[p][r] - mn); sp[p][r] = e; ls += e; }
            lrun = lrun * alpha + ls;
#pragma unroll
            for (int r = 0; r < 16; ++r) { ot0[r] *= alpha; ot1[r] *= alpha; }
            bf16x8 pf[4];
#pragma unroll
            for (int c = 0; c < 4; ++c) { const int p = c >> 1, s8 = 8 * (c & 1);
                pf[c] = pack8(sp[p][s8 + 0], sp[p][s8 + 1], sp[p][s8 + 2], sp[p][s8 + 3], sp[p][s8 + 4], sp[p][s8 + 5], sp[p][s8 + 6], sp[p][s8 + 7]); }
#pragma unroll
            for (int c = 0; c < 4; ++c) {
                const bf16x8 v0 = *(LAS const bf16x8*)(Vb + (a) * 144 + (16 * c + 8 * hi) * 2);
                const bf16x8 v1 = *(LAS const bf16x8*)(Vb + (32 + a) * 144 + (16 * c + 8 * hi) * 2);
                ot0 = MFMA32(v0, pf[c], ot0); ot1 = MFMA32(v1, pf[c], ot1);
            }
            }
        }
        if (it + 1 < ntiles) AT_STORE(buf ^ 1);
        __syncthreads();
    }
#undef AT_STORE
    lrun += shx(lrun, 32, lane);
    const float inv = 1.0f / lrun;
    bf16* yp = ycat + (rowbase + q0 + qi) * D + 256 + 64 * h + 4 * hi;
#pragma unroll
    for (int g = 0; g < 4; ++g) {
        u32x2 w0; w0.x = pk2(ot0[4 * g] * inv, ot0[4 * g + 1] * inv); w0.y = pk2(ot0[4 * g + 2] * inv, ot0[4 * g + 3] * inv);
        u32x2 w1; w1.x = pk2(ot1[4 * g] * inv, ot1[4 * g + 1] * inv); w1.y = pk2(ot1[4 * g + 2] * inv, ot1[4 * g + 3] * inv);
        *(u32x2*)(yp + 8 * g) = w0; *(u32x2*)(yp + 32 + 8 * g) = w1;
    }
}
DI void attn_block(const KP& P, int L, LAS unsigned char* lds, int u, int tid, int lane, int wid) {
    const int bh = u >> 4, j = u & 15, b = bh >> 2, h = bh & 3;
    const bf16* hb = (const bf16*)(kp_ws(P) + WS_H); bf16* ycat = (bf16*)(kp_ws(P) + WS_YCAT);
    const float* sm = (const float*)(kp_ws(P) + WS_SMALL);
    LAS float* Fs = (LAS float*)lds; LAS float* red = (LAS float*)(lds + AT_RED);
    const int n = 256 * (32 - j);
    const float bf = PIN(P, 15)[L * 4 + h];
    const float* fl = sm + (size_t)b * SEQ * 16 + h;
    const int s0 = tid * 16;
    float loc[16]; float run = 0.f;
    __syncthreads();
#pragma unroll
    for (int i = 0; i < 16; ++i) { float lf = 0.f; if (s0 < n) { const float v = fl[(size_t)(s0 + i) * 16] + bf; lf = -softplusf(-v); } run += lf; loc[i] = run; }
    float incl = run;
#pragma unroll
    for (int o = 1; o < 64; o <<= 1) { const float t = shup(incl, o, lane); if (lane >= o) incl += t; }
    if (lane == 63) red[wid] = incl;
    __syncthreads();
    float base = incl - run;
    for (int w = 0; w < wid; ++w) base += red[w];
    if (s0 < n) {
#pragma unroll
        for (int i = 0; i < 16; ++i) Fs[s0 + i] = (base + loc[i]) * LOG2E;
    }
    __syncthreads();
    attn_unit(hb, ycat, lds, b, h, 31 - j, tid, lane, wid);
    attn_unit(hb, ycat, lds, b, h, j, tid, lane, wid);
}
constexpr int LR_UF = 16896, LR_AS = LR_UF + 32768, LR_BS = LR_AS + 32768, LR_GS = LR_BS + 32768;
DI float gelu_tanh(float x) { const float y = 0.7978845608028654f * (x + 0.044715f * x * x * x); const float t = 1.0f - 2.0f / (__expf(2.0f * y) + 1.0f); return 0.5f * x * (1.0f + t); }
template <bool PASS2>
DI void lru_unit(const KP& P, int L, LAS unsigned char* lds, int b, int c, int tid, int lane, int wid) {
    const bf16* hb = (const bf16*)(kp_ws(P) + WS_H); bf16* ycat = (bf16*)(kp_ws(P) + WS_YCAT);
    float* agg = (float*)(kp_ws(P) + WS_MISC + MISC_AGG); const float* carry = (const float*)(kp_ws(P) + WS_MISC + MISC_CARRY);
    const float* cw = PIN(P, 8) + (size_t)L * 4 * 256; const float* cb = PIN(P, 9) + (size_t)L * 256;
    const float* ba = PIN(P, 11) + (size_t)L * 256; const float* bx = PIN(P, 13) + (size_t)L * 256; const float* lam = PIN(P, 14) + (size_t)L * 256;
    const bf16* waT = (const bf16*)(kp_ws(P) + WS_W0 + (size_t)L * WS_WL + OFF_LRUW); const bf16* wxT = waT + 16384;
    LAS unsigned char* Ubf = lds; LAS float* Uf = (LAS float*)(lds + LR_UF); LAS float* As = (LAS float*)(lds + LR_AS); LAS float* Bs = (LAS float*)(lds + LR_BS);
    LAS unsigned short* Gs = (LAS unsigned short*)(lds + LR_GS);
    const int ch = tid & 255, hi = lane >> 5;
    const int cg = tid & 31, t2 = tid >> 5;
    float w0[8], w1[8], w2[8], w3[8], cbv[8];
#pragma unroll
    for (int j = 0; j < 8; ++j) { w0[j] = cw[8 * cg + j]; w1[j] = cw[256 + 8 * cg + j]; w2[j] = cw[512 + 8 * cg + j]; w3[j] = cw[768 + 8 * cg + j]; cbv[j] = cb[8 * cg + j]; }
    const int hd = wid >> 1, nh = wid & 1, nn = 32 * nh + (lane & 31), chn = 64 * hd + nn;
    bf16x8 wfa[4], wfx[4];
#pragma unroll
    for (int kc = 0; kc < 4; ++kc) { wfa[kc] = *(const bf16x8*)(waT + (hd * 64 + nn) * 64 + 16 * kc + 8 * hi); wfx[kc] = *(const bf16x8*)(wxT + (hd * 64 + nn) * 64 + 16 * kc + 8 * hi); }
    const float ba_c = ba[chn], bx_c = bx[chn], spl = 8.0f * softplusf(-lam[chn]);
    float hstate = 0.f, aprod = 1.f;
    if (PASS2) hstate = carry[((size_t)b * 64 + c) * 256 + ch];
    const size_t t0 = (size_t)b * SEQ + 128 * c;
    u32x4 raw[5]; u32x4 graw[2];
#define LRU_LOAD(sub_) do { const size_t ts_ = t0 + 32 * (sub_); const int pos_ = 128 * c + 32 * (sub_) + 2 * t2; const bf16* up_ = hb + (ts_ + 2 * t2) * HBW + HB_U + 8 * cg; \
        _Pragma("unroll") for (int i_ = 0; i_ < 3; ++i_) raw[i_] = (pos_ + i_ - 3 >= 0) ? *(const u32x4*)(up_ + (ptrdiff_t)(i_ - 3) * HBW) : (u32x4){0u, 0u, 0u, 0u}; \
        raw[3] = *(const u32x4*)up_; raw[4] = *(const u32x4*)(up_ + HBW); \
        if (PASS2) { const bf16* gp_ = hb + (ts_ + t2) * HBW + HB_G + 8 * cg; graw[0] = *(const u32x4*)gp_; graw[1] = *(const u32x4*)(gp_ + (size_t)16 * HBW); } } while (0)
    LRU_LOAD(0);
    __syncthreads();
    for (int sub = 0; sub < 4; ++sub) {
        const size_t ts = t0 + 32 * sub;
#pragma unroll
        for (int q = 0; q < 2; ++q) {
            float o[8];
#pragma unroll
            for (int j = 0; j < 8; ++j) o[j] = w0[j] * bfsel(raw[q], j) + w1[j] * bfsel(raw[q + 1], j) + w2[j] * bfsel(raw[q + 2], j) + w3[j] * bfsel(raw[q + 3], j) + cbv[j];
            const int t = 2 * t2 + q;
            *(LAS f32x4*)(Uf + t * 256 + 8 * cg) = (f32x4){o[0], o[1], o[2], o[3]}; *(LAS f32x4*)(Uf + t * 256 + 8 * cg + 4) = (f32x4){o[4], o[5], o[6], o[7]};
            u32x4 w; w.x = pk2(o[0], o[1]); w.y = pk2(o[2], o[3]); w.z = pk2(o[4], o[5]); w.w = pk2(o[6], o[7]);
            *(LAS u32x4*)(Ubf + t * 528 + 16 * cg) = w;
        }
        if (PASS2) { *(LAS u32x4*)((LAS unsigned char*)Gs + t2 * 512 + 16 * cg) = graw[0]; *(LAS u32x4*)((LAS unsigned char*)Gs + (t2 + 16) * 512 + 16 * cg) = graw[1]; }
        if (sub < 3) LRU_LOAD(sub + 1);
        __syncthreads();
        {
            f32x16 ga, gx;
#pragma unroll
            for (int r = 0; r < 16; ++r) { ga[r] = 0.f; gx[r] = 0.f; }
#pragma unroll
            for (int kc = 0; kc < 4; ++kc) { const bf16x8 af = *(LAS const bf16x8*)(Ubf + (lane & 31) * 528 + (64 * hd + 16 * kc + 8 * hi) * 2);
                ga = MFMA32(af, wfa[kc], ga); gx = MFMA32(af, wfx[kc], gx); }
#pragma unroll
            for (int r = 0; r < 16; ++r) { const int t = crow(r, hi); const float uu = Uf[t * 256 + chn];
                const float rg = sigmoidf_(ga[r] + ba_c), ig = sigmoidf_(gx[r] + bx_c), la = -spl * rg;
                As[t * 256 + chn] = __expf(la); Bs[t * 256 + chn] = sqrtf(fmaxf(-expm1f(2.0f * la), 0.f)) * ig * uu; }
        }
        __syncthreads();
        if (tid < 256) {
#pragma unroll 8
            for (int t = 0; t < 32; ++t) { const float av = As[t * 256 + ch], bv = Bs[t * 256 + ch]; hstate = av * hstate + bv; aprod *= av;
                if (PASS2) { const float gt = bf2f(Gs[t * 256 + ch]); ycat[(ts + t) * D + ch] = (bf16)(pk2(hstate * gelu_tanh(gt), 0.f) & 0xffffu); } }
        }
        __syncthreads();
    }
#undef LRU_LOAD
    if (!PASS2 && tid < 256) { agg[(((size_t)b * 64 + c) * 256 + ch) * 2] = aprod; agg[(((size_t)b * 64 + c) * 256 + ch) * 2 + 1] = hstate; }
}
DI void lru_carry(const KP& P, int tid, int bxo) {
    const float* agg = (const float*)(kp_ws(P) + WS_MISC + MISC_AGG); float* carry = (float*)(kp_ws(P) + WS_MISC + MISC_CARRY);
    const int e = bxo * NTH + tid;
    if (e < 1024) { const int b = e >> 8, ch = e & 255; float h = 0.f;
        for (int c = 0; c < 64; ++c) { const size_t i = ((size_t)b * 64 + c) * 256 + ch; carry[i] = h; h = agg[2 * i] * h + agg[2 * i + 1]; } }
}
constexpr int SD_XT = 0, SD_B = 69632, SD_C = 104448, SD_DT = 139264, SD_AC = 141312, SD_FR = 143360;
template <bool PASS2>
DI void ssd_conv(const KP& P, int L, LAS unsigned char* lds, int b, int c, int g, int tid) {
    const bf16* hb = (const bf16*)(kp_ws(P) + WS_H);
    const int cg = tid & 63, tr = tid >> 6;
    if (!PASS2 && cg >= 48) return;
    const int cc = cg < 32 ? 256 * g + 8 * cg : (cg < 48 ? 512 + 128 * g + 8 * (cg - 32) : 768 + 128 * g + 8 * (cg - 48));
    const size_t t0 = (size_t)b * SEQ + 128 * c;
    const bf16* up = hb + (t0 + 16 * tr) * HBW + HB_X + cc;
    u32x4 raw[19];
    const bool has_prev = (c > 0) || (tr > 0);
#pragma unroll
    for (int i = 0; i < 3; ++i) raw[i] = has_prev ? *(const u32x4*)(up + (ptrdiff_t)(i - 3) * HBW) : (u32x4){0u, 0u, 0u, 0u};
#pragma unroll
    for (int i = 0; i < 16; ++i) raw[3 + i] = *(const u32x4*)(up + (size_t)i * HBW);
    const float* cw = PIN(P, 16) + (size_t)L * 4 * 1024 + cc; const float* cbp = PIN(P, 17) + (size_t)L * 1024 + cc;
    if (!PASS2 || cg < 32) {
        LAS unsigned char* dst = lds + (cg < 32 ? SD_XT + (8 * cg) * 272 : SD_B + (8 * (cg - 32)) * 272) + 32 * tr;
#pragma unroll
        for (int j = 0; j < 8; ++j) {
            const float w0 = cw[j], w1 = cw[1024 + j], w2 = cw[2048 + j], w3 = cw[3072 + j], bb = cbp[j];
            float o[16];
#pragma unroll
            for (int i = 0; i < 16; ++i) { const float y = w0 * bfsel(raw[i], j) + w1 * bfsel(raw[i + 1], j) + w2 * bfsel(raw[i + 2], j) + w3 * bfsel(raw[i + 3], j) + bb; o[i] = y * sigmoidf_(y); }
            u32x4 wa, wb; wa.x = pk2(o[0], o[1]); wa.y = pk2(o[2], o[3]); wa.z = pk2(o[4], o[5]); wa.w = pk2(o[6], o[7]); wb.x = pk2(o[8], o[9]); wb.y = pk2(o[10], o[11]); wb.z = pk2(o[12], o[13]); wb.w = pk2(o[14], o[15]);
            *(LAS u32x4*)(dst + j * 272) = wa; *(LAS u32x4*)(dst + j * 272 + 16) = wb;
        }
    } else {
        LAS unsigned char* dst = lds + (cg < 48 ? SD_B + 16 * (cg - 32) : SD_C + 16 * (cg - 48)) + (16 * tr) * 272;
        float w0[8], w1[8], w2[8], w3[8], bb[8];
#pragma unroll
        for (int j = 0; j < 8; ++j) { w0[j] = cw[j]; w1[j] = cw[1024 + j]; w2[j] = cw[2048 + j]; w3[j] = cw[3072 + j]; bb[j] = cbp[j]; }
#pragma unroll
        for (int i = 0; i < 16; ++i) {
            float o[8];
#pragma unroll
            for (int j = 0; j < 8; ++j) { const float y = w0[j] * bfsel(raw[i], j) + w1[j] * bfsel(raw[i + 1], j) + w2[j] * bfsel(raw[i + 2], j) + w3[j] * bfsel(raw[i + 3], j) + bb[j]; o[j] = y * sigmoidf_(y); }
            u32x4 w; w.x = pk2(o[0], o[1]); w.y = pk2(o[2], o[3]); w.z = pk2(o[4], o[5]); w.w = pk2(o[6], o[7]);
            *(LAS u32x4*)(dst + i * 272) = w;
        }
    }
}
DI void ssd_dt(const KP& P, int L, LAS unsigned char* lds, int b, int c, int g, int tid, int lane, int wid) {
    const float* sm = (const float*)(kp_ws(P) + WS_SMALL);
    LAS float* dtS = (LAS float*)(lds + SD_DT); LAS float* acS = (LAS float*)(lds + SD_AC);
    const size_t t0 = (size_t)b * SEQ + 128 * c;
    { const int hh = tid >> 7, t = tid & 127, hg = 4 * g + hh;
      const float dtv = softplusf(sm[(t0 + t) * 16 + 4 + hg] + PIN(P, 18)[L * 8 + hg]); dtS[hh * 128 + t] = dtv; acS[hh * 128 + t] = -__expf(PIN(P, 19)[L * 8 + hg]) * dtv; }
    __syncthreads();
    if (wid < 4) { const float a0 = acS[wid * 128 + 2 * lane], a1 = acS[wid * 128 + 2 * lane + 1]; const float s = a0 + a1; float incl = s;
#pragma unroll
        for (int o = 1; o < 64; o <<= 1) { const float t = shup(incl, o, lane); if (lane >= o) incl += t; }
        const float ex = incl - s; acS[wid * 128 + 2 * lane] = ex + a0; acS[wid * 128 + 2 * lane + 1] = ex + s; }
    __syncthreads();
}
DI void ssd_pass1(const KP& P, int L, LAS unsigned char* lds, int b, int c, int g, int tid, int lane, int wid) {
    float* state = (float*)(kp_ws(P) + WS_STATE); float* atot = (float*)(kp_ws(P) + WS_MISC + MISC_ATOT);
    LAS float* dtS = (LAS float*)(lds + SD_DT); LAS float* acS = (LAS float*)(lds + SD_AC); LAS float* facS = (LAS float*)(lds + SD_FR);
    __syncthreads();
    ssd_conv<false>(P, L, lds, b, c, g, tid);
    ssd_dt(P, L, lds, b, c, g, tid, lane, wid);
    { const int hh = tid >> 7, t = tid & 127; facS[hh * 128 + t] = dtS[hh * 128 + t] * __expf(acS[hh * 128 + 127] - acS[hh * 128 + t]);
      if (t == 127) atot[((size_t)b * 64 + c) * 8 + 4 * g + hh] = acS[hh * 128 + 127]; }
    __syncthreads();
    const int hh = wid >> 1, pb = wid & 1, a = lane & 31, hi = lane >> 5;
    f32x16 acc[4];
#pragma unroll
    for (int nb = 0; nb < 4; ++nb)
#pragma unroll
        for (int r = 0; r < 16; ++r) acc[nb][r] = 0.f;
#pragma unroll 2
    for (int kc = 0; kc < 8; ++kc) {
        const u32x4 w = *(LAS const u32x4*)(lds + SD_XT + (64 * hh + 32 * pb + a) * 272 + (16 * kc + 8 * hi) * 2);
        LAS const float* fp = facS + hh * 128 + 16 * kc + 8 * hi;
        const f32x4 fa = *(LAS const f32x4*)fp, fb = *(LAS const f32x4*)(fp + 4);
        const bf16x8 af = pack8(bflo(w.x) * fa[0], bfhi(w.x) * fa[1], bflo(w.y) * fa[2], bfhi(w.y) * fa[3], bflo(w.z) * fb[0], bfhi(w.z) * fb[1], bflo(w.w) * fb[2], bfhi(w.w) * fb[3]);
#pragma unroll
        for (int nb = 0; nb < 4; ++nb) { const bf16x8 bfr = *(LAS const bf16x8*)(lds + SD_B + (32 * nb + a) * 272 + (16 * kc + 8 * hi) * 2); acc[nb] = MFMA32(af, bfr, acc[nb]); }
    }
    float* sg = state + ((((size_t)b * 64 + c) * 8 + 4 * g + hh) * 64 + 32 * pb) * 128;
#pragma unroll
    for (int nb = 0; nb < 4; ++nb)
#pragma unroll
        for (int r = 0; r < 16; ++r) sg[(size_t)crow(r, hi) * 128 + 32 * nb + a] = acc[nb][r];
}
DI void ssd_rec(const KP& P, int tid, int bxo, int Go) {
    float* state = (float*)(kp_ws(P) + WS_STATE); const float* atot = (const float*)(kp_ws(P) + WS_MISC + MISC_ATOT);
    const int NT = Go * NTH;
    for (int e = bxo * NTH + tid; e < 4 * 8 * 8192; e += NT) {
        const int b = e >> 16, hg = (e >> 13) & 7, pn = e & 8191;
        float* ptr = state + ((size_t)b * 64 * 8 + hg) * 8192 + pn; const float* at = atot + (size_t)b * 64 * 8 + hg;
        float E = 0.f;
        for (int c = 0; c < 64; c += 8) {
            float s[8], dk[8];
#pragma unroll
            for (int i = 0; i < 8; ++i) { s[i] = ptr[(size_t)(c + i) * 8 * 8192]; dk[i] = __expf(at[(c + i) * 8]); }
#pragma unroll
            for (int i = 0; i < 8; ++i) { ptr[(size_t)(c + i) * 8 * 8192] = E; E = dk[i] * E + s[i]; }
        }
    }
}
DI void ssd_pass2(const KP& P, int L, LAS unsigned char* lds, int b, int c, int g, int tid, int lane, int wid) {
    LAS float* dtS = (LAS float*)(lds + SD_DT); LAS float* acS = (LAS float*)(lds + SD_AC); LAS float* red = (LAS float*)(lds + SD_FR);
    __syncthreads();
    ssd_conv<true>(P, L, lds, b, c, g, tid);
    ssd_dt(P, L, lds, b, c, g, tid, lane, wid);
    const int lb = wid & 3, hp = wid >> 2, a = lane & 31, hi = lane >> 5, pa = (a & 0x13) | ((a & 4) << 1) | ((a & 8) >> 1);
    const int ll = 32 * lb + a;
    const size_t t0 = (size_t)b * SEQ + 128 * c;
    f32x16 yk[2][2];
#pragma unroll
    for (int hq = 0; hq < 2; ++hq)
#pragma unroll
        for (int pb = 0; pb < 2; ++pb)
#pragma unroll
            for (int r = 0; r < 16; ++r) yk[hq][pb][r] = 0.f;
    for (int sb = 0; sb <= lb; ++sb) {
        f32x16 gt;
#pragma unroll
        for (int r = 0; r < 16; ++r) gt[r] = 0.f;
#pragma unroll 2
        for (int kc = 0; kc < 8; ++kc) {
            const bf16x8 cf = *(LAS const bf16x8*)(lds + SD_C + ll * 272 + (16 * kc + 8 * hi) * 2);
            const bf16x8 bfr = *(LAS const bf16x8*)(lds + SD_B + (32 * sb + pa) * 272 + (16 * kc + 8 * hi) * 2);
            gt = MFMA32(bfr, cf, gt);
        }
#pragma unroll
        for (int hq = 0; hq < 2; ++hq) {
            const int hh = 2 * hp + hq;
            const float acl = acS[hh * 128 + ll];
#pragma unroll
            for (int sc = 0; sc < 2; ++sc) {
                const int sbase = 32 * sb + 16 * sc + 8 * hi;
                LAS const float* ap = acS + hh * 128 + sbase; LAS const float* dp = dtS + hh * 128 + sbase;
                const f32x4 a0 = *(LAS const f32x4*)ap, a1 = *(LAS const f32x4*)(ap + 4), d0 = *(LAS const f32x4*)dp, d1 = *(LAS const f32x4*)(dp + 4);
                float mv[8];
#pragma unroll
                for (int j = 0; j < 8; ++j) { const float as = j < 4 ? a0[j & 3] : a1[j & 3], ds = j < 4 ? d0[j & 3] : d1[j & 3];
                    const float v = gt[8 * sc + j] * __expf(acl - as) * ds; mv[j] = (sbase + j <= ll) ? v : 0.f; }
                const bf16x8 mf = pack8(mv[0], mv[1], mv[2], mv[3], mv[4], mv[5], mv[6], mv[7]);
#pragma unroll
                for (int pb = 0; pb < 2; ++pb) { const bf16x8 xf = *(LAS const bf16x8*)(lds + SD_XT + (64 * hh + 32 * pb + a) * 272 + sbase * 2); yk[hq][pb] = MFMA32(xf, mf, yk[hq][pb]); }
            }
        }
    }
    float ss = 0.f;
#pragma unroll
    for (int hq = 0; hq < 2; ++hq) {
        const int hh = 2 * hp + hq, hg = 4 * g + hh;
        const float acl = acS[hh * 128 + ll];
        f32x16 yo[2];
#pragma unroll
        for (int pb = 0; pb < 2; ++pb)
#pragma unroll
            for (int r = 0; r < 16; ++r) yo[pb][r] = 0.f;
        const float* eg = (const float*)(kp_ws(P) + WS_STATE) + ((((size_t)b * 64 + c) * 8 + hg) * 64) * 128;
#pragma unroll 2
        for (int kc = 0; kc < 8; ++kc) {
            const bf16x8 cf = *(LAS const bf16x8*)(lds + SD_C + ll * 272 + (16 * kc + 8 * hi) * 2);
#pragma unroll
            for (int pb = 0; pb < 2; ++pb) { const float* ep = eg + (size_t)(32 * pb + a) * 128 + 16 * kc + 8 * hi; const f32x4 e0 = *(const f32x4*)ep, e1 = *(const f32x4*)(ep + 4);
                const bf16x8 ef = pack8(e0[0], e0[1], e0[2], e0[3], e1[0], e1[1], e1[2], e1[3]); yo[pb] = MFMA32(ef, cf, yo[pb]); }
        }
        const float eal = __expf(acl), dsk = PIN(P, 20)[L * 8 + hg];
        const bf16* hb = (const bf16*)(kp_ws(P) + WS_H);
#pragma unroll
        for (int pb = 0; pb < 2; ++pb)
#pragma unroll
            for (int q4 = 0; q4 < 4; ++q4) {
                const int p0 = 32 * pb + 8 * q4 + 4 * hi;
                const u32x2 zw = *(const u32x2*)(hb + (t0 + ll) * HBW + HB_Z + 256 * g + 64 * hh + p0);
                const float zz[4] = {bflo(zw.x), bfhi(zw.x), bflo(zw.y), bfhi(zw.y)};
#pragma unroll
                for (int j = 0; j < 4; ++j) { const int r = 4 * q4 + j;
                    const float xs = bf2f(*(LAS const unsigned short*)(lds + SD_XT + (64 * hh + p0 + j) * 272 + ll * 2));
                    float y = yk[hq][pb][r] + eal * yo[pb][r] + dsk * xs; y = y * (zz[j] * sigmoidf_(zz[j])); yk[hq][pb][r] = y; ss += y * y; }
            }
    }
    ss += shx(ss, 32, lane);
    if (hi == 0) red[hp * 128 + ll] = ss;
    __syncthreads();
    const float rstd = 1.0f / sqrtf((red[ll] + red[128 + ll]) * (1.0f / 256.0f) + RMS_EPS);
    const float* ng = PIN(P, 21) + (size_t)L * 512 + 256 * g; bf16* ycat = (bf16*)(kp_ws(P) + WS_YCAT);
#pragma unroll
    for (int hq = 0; hq < 2; ++hq)
#pragma unroll
        for (int pb = 0; pb < 2; ++pb)
#pragma unroll
            for (int q4 = 0; q4 < 4; ++q4) { const int hh = 2 * hp + hq, p0 = 32 * pb + 8 * q4 + 4 * hi; const f32x4 gg = *(const f32x4*)(ng + 64 * hh + p0);
                u32x2 w; w.x = pk2(yk[hq][pb][4 * q4] * rstd * gg[0], yk[hq][pb][4 * q4 + 1] * rstd * gg[1]); w.y = pk2(yk[hq][pb][4 * q4 + 2] * rstd * gg[2], yk[hq][pb][4 * q4 + 3] * rstd * gg[3]);
                *(u32x2*)(ycat + (t0 + ll) * D + 512 + 256 * g + 64 * hh + p0) = w; }
}
#define GEMM_PHASE(EpiT, Aptr, Bptr, Nn, Kk, Eobj) do { pg8::Gemm g_{(const pg8::bf16_t*)(Aptr), (const pg8::bf16_t*)(Bptr), M, (Nn), (Kk)}; int G_o = (int)gridDim.x, c_o = (int)blockIdx.x; asm volatile("" : "+s"(G_o), "+s"(c_o)); pg8::StaticOrder S_; S_.init(M, (Nn), G_o, c_o); \
    pg8::gemm_phase<EpiT, pg8::StaticOrder, true, true>(lds, g_, S_, (Eobj), wid_s * 64 + lane_id_asm()); } while (0)

#define TID_NEW int wid_o = wid_s, bxo = (int)blockIdx.x, Go = (int)gridDim.x; asm volatile("" : "+s"(wid_o), "+s"(bxo), "+s"(Go)); const int wid = wid_o, lane = lane_id_asm(), tid = wid * 64 + lane
#define GBARK(k) do { grid_bar((unsigned*)kp_ws(P), (unsigned)(L * 13 + (k)) * (unsigned)gridDim.x, wid_s * 64 + lane_id_asm()); } while (0)
#define G Go
#define bx bxo
#define ws kp_ws(P)
#define xbA ((bf16*)(ws + WS_XBA))
#define xbB ((bf16*)(ws + WS_XBB))
#define Hb ((bf16*)(ws + WS_H))
#define sm ((float*)(ws + WS_SMALL))
#define ycat ((bf16*)(ws + WS_YCAT))
#define Pf ((float*)(ws + WS_H))
#define xo kp_out(P)

template <int L>
__device__ __forceinline__ void layer_fwd(const KP& P, LAS unsigned char* lds, const int wid_s) {
#define wl (ws + WS_W0 + (size_t)L * WS_WL)
#ifndef NO_G1
        { pg8::EpiSwiGLU E{&P}; GEMM_PHASE(pg8::EpiSwiGLU, xbA, wl + OFF_UP1, 2 * FF, D, E); }
#ifdef PROBE_A
        { pg8::EpiSwiGLU E{&P}; GEMM_PHASE(pg8::EpiSwiGLU, xbA, wl + OFF_UP1, 2 * FF, D, E); }
#endif
#endif
        GBARK(1);
#ifndef NO_G2
        { pg8::EpiResid E{&P, L == 0 ? 1 : 0, 0.5f}; GEMM_PHASE(pg8::EpiResid, Hb, wl + OFF_DN1, D, FF, E); }
#endif
        GBARK(2);
#ifndef NO_LN
        { TID_NEW; ln_phase(xo, PIN(P, 2) + L * D, PIN(P, 3) + L * D, xbB, lane, wid, bxo, Go); }
#endif
        GBARK(3);
#ifndef NO_G3
        { pg8::EpiIn E{&P}; GEMM_PHASE(pg8::EpiIn, xbB, wl + OFF_WIN, NIN, D, E); }
#endif
        GBARK(4);
#ifndef NO_ATTN
        { TID_NEW; for (int u = bx; u < 256; u += G) attn_block(P, L, lds, u, tid, lane, wid);
        }
#ifdef PROBE_B
        { TID_NEW; for (int u = bx; u < 256; u += G) attn_block(P, L, lds, u, tid, lane, wid);
        }
#endif
#endif
#ifndef NO_SSD1
        { TID_NEW; for (int u = bx; u < 512; u += G) ssd_pass1(P, L, lds, u >> 7, (u >> 1) & 63, u & 1, tid, lane, wid);
        }
#endif
#ifndef NO_LRU
        { TID_NEW; for (int u = bx; u < 256; u += G) lru_unit<false>(P, L, lds, u >> 6, u & 63, tid, lane, wid);
        }
#endif
#ifdef PROBE_C
        { TID_NEW; for (int u = bx; u < 512; u += G) ssd_pass1(P, L, lds, u >> 7, (u >> 1) & 63, u & 1, tid, lane, wid);
        }
        { TID_NEW; for (int u = bx; u < 256; u += G) lru_unit<false>(P, L, lds, u >> 6, u & 63, tid, lane, wid);
        }
#endif
        GBARK(5);
#ifndef NO_REC
        { TID_NEW; ssd_rec(P, tid, bxo, Go); lru_carry(P, tid, bxo); }
#endif
        GBARK(6);
#ifndef NO_SSD2
        { TID_NEW; for (int u = bx; u < 512; u += G) ssd_pass2(P, L, lds, u >> 7, (u >> 1) & 63, u & 1, tid, lane, wid);
        }
#endif
#ifndef NO_LRU
        { TID_NEW; for (int u = bx; u < 256; u += G) lru_unit<true>(P, L, lds, u >> 6, u & 63, tid, lane, wid);
        }
#endif
#ifdef PROBE_C
        { TID_NEW; for (int u = bx; u < 512; u += G) ssd_pass2(P, L, lds, u >> 7, (u >> 1) & 63, u & 1, tid, lane, wid);
        }
        { TID_NEW; for (int u = bx; u < 256; u += G) lru_unit<true>(P, L, lds, u >> 6, u & 63, tid, lane, wid);
        }
#endif
        GBARK(7);
#ifndef NO_G4
        { pg8::EpiResid E{&P, 0, 1.0f}; GEMM_PHASE(pg8::EpiResid, ycat, wl + OFF_WOUT, D, D, E); }
#endif
        GBARK(8);
#ifndef NO_LN
        { TID_NEW; ln_phase(xo, PIN(P, 23) + L * D, PIN(P, 24) + L * D, xbA, lane, wid, bxo, Go); }
#endif
        GBARK(9);
#ifndef NO_G5
        { pg8::EpiSwiGLU E{&P}; GEMM_PHASE(pg8::EpiSwiGLU, xbA, wl + OFF_UP2, 2 * FF, D, E); }
#ifdef PROBE_A
        { pg8::EpiSwiGLU E{&P}; GEMM_PHASE(pg8::EpiSwiGLU, xbA, wl + OFF_UP2, 2 * FF, D, E); }
#endif
#endif
        GBARK(10);
#ifndef NO_G6
        { pg8::EpiResid E{&P, 0, 0.5f}; GEMM_PHASE(pg8::EpiResid, Hb, wl + OFF_DN2, D, FF, E); }
#endif
        GBARK(11);
#ifndef NO_LN
        { TID_NEW; ln_phase(xo, PIN(P, 28) + L * D, PIN(P, 29) + L * D, xbB, lane, wid, bxo, Go); }
#endif
#ifndef NO_G7
        { pg8::EpiF32 E{&P}; GEMM_PHASE(pg8::EpiF32, ws + WS_PB + (size_t)L * M * 256 * 2, wl + OFF_PROJ, D, 256, E); }
#endif
        GBARK(12);
#ifndef NO_G8
        { pg8::EpiPE E{&P, L}; GEMM_PHASE(pg8::EpiPE, xbB, wl + OFF_GATE, D, D, E); }
#endif
        if (L == 0) GBARK(13);
}

__global__ void __launch_bounds__(NTH, 2) hymba_fwd(KP P) {
    extern __shared__ __attribute__((aligned(16))) unsigned char lds_raw[];
    LAS unsigned char* lds = (LAS unsigned char*)lds_raw;
    cg::grid_group grid = cg::this_grid();
    const int wid_s = __builtin_amdgcn_readfirstlane((int)threadIdx.x >> 6);
#ifndef NO_PRO
    { TID_NEW; prologue(P, lds, tid, lane, wid, bxo, Go); }
#endif
    grid.sync();
    layer_fwd<0>(P, lds, wid_s);
    layer_fwd<1>(P, lds, wid_s);
}

#undef G
#undef bx
#undef ws
#undef xbA
#undef xbB
#undef Hb
#undef sm
#undef ycat
#undef Pf
#undef xo
#undef wl
extern "C" void kernel_launch(void* const* d_in, const int* in_sizes, int n_in, void* d_out, int out_size, void* d_ws, size_t ws_size, hipStream_t stream) {
    static int grid = 0;
    if (grid == 0) {
        if (n_in != 33 || out_size != M * D || ws_size < WS_END) { fprintf(stderr, "kernel_launch: unexpected shapes (n_in %d out %d ws %zu)\n", n_in, out_size, ws_size); grid = -1; return; }
        int dev = 0, cus = 0, per_cu = 0;
        (void)hipGetDevice(&dev); (void)hipDeviceGetAttribute(&cus, hipDeviceAttributeMultiprocessorCount, dev);
        if (hipFuncSetAttribute((const void*)hymba_fwd, hipFuncAttributeMaxDynamicSharedMemorySize, LDS_BYTES) != hipSuccess) { fprintf(stderr, "kernel_launch: hipFuncSetAttribute failed\n"); grid = -1; return; }
        if (hipOccupancyMaxActiveBlocksPerMultiprocessor(&per_cu, (const void*)hymba_fwd, NTH, LDS_BYTES) != hipSuccess || per_cu < 1) { fprintf(stderr, "kernel_launch: occupancy query gave %d\n", per_cu); per_cu = 1; }
        (void)hipGetLastError();
        grid = cus * 1;
        if (grid > 256) grid = 256;
    }
    if (grid < 0) return;
    if (hipMemsetAsync(d_ws, 0, 256, stream) != hipSuccess) { fprintf(stderr, "kernel_launch: memset of the barrier word failed\n"); return; }
    KP p{};
    for (int i = 0; i < 33; ++i) p.in[i] = (const float*)d_in[i];
    p.out = (float*)d_out; p.ws = (unsigned char*)d_ws;
    void* args[] = {&p};
    hipError_t e = hipLaunchCooperativeKernel((const void*)hymba_fwd, dim3(grid), dim3(NTH), args, LDS_BYTES, stream);
    if (e != hipSuccess) fprintf(stderr, "cooperative launch failed: %s (grid %d)\n", hipGetErrorString(e), grid);
}
```
